# Optimizing an MI355X kernel written in HIP

```python
import math
import jax
import jax.numpy as jnp
from jax import lax
import numpy as np

D_MODEL = 1024
BATCH = 4
SEQ = 4096
DEPTH = 4

GRID_W = 64
CTX_LEN = 256
EPS = 1e-6
F32 = jnp.float32

S5_GROUP = 16
S5_GROUPS = 16
S5_WIDTH = S5_GROUPS * S5_GROUP
S5_STATE = 64

MLA_HEADS = 8
MLA_NOPE = 64
MLA_ROPE = 32
MLA_V = 64
MLA_DH = MLA_NOPE + MLA_ROPE
MLA_Q_RANK = 256
MLA_KV_RANK = 128
MLA_WIDTH = MLA_HEADS * MLA_V
ROPE_BASE = 10000.0
ROPE_FREQS = MLA_ROPE // 4
Q_BLOCK = 128

DN_HEADS = 4
DN_DK = 64
DN_DV = 64
DN_QKV = DN_HEADS * (2 * DN_DK + DN_DV)
DN_WIDTH = DN_HEADS * DN_DV
DN_CONV = 5
DN_CHUNK = 64

D_MIX = S5_WIDTH + MLA_WIDTH + DN_WIDTH
D_FF = 4 * D_MODEL
IN_SIZES = (S5_WIDTH, MLA_Q_RANK, MLA_KV_RANK, MLA_ROPE, DN_QKV, DN_WIDTH, 4 * DN_HEADS)
IN_WIDTH = sum(IN_SIZES)

kernel_name = "hybrid_s5_mla_gdn_dit_trunk"


def _rms(x, w):
    xf = x.astype(F32)
    y = xf * lax.rsqrt(jnp.mean(xf * xf, axis=-1, keepdims=True) + EPS)
    return y.astype(x.dtype) * w


def _l2norm(x):
    xf = x.astype(F32)
    return xf * lax.rsqrt(jnp.sum(xf * xf, axis=-1, keepdims=True) + EPS)


def _modulate(x, w, shift, scale):
    return _rms(x, w) * (1.0 + scale) + shift


def _split_in(z):
    parts, start = [], 0
    for size in IN_SIZES:
        parts.append(z[..., start:start + size])
        start += size
    return parts


def _cmul(ar, ai, br, bi):
    return ar * br - ai * bi, ar * bi + ai * br


def _s5_discretize(lam_re, lam_im, log_dt, b_re, b_im):
    dt = jnp.exp(log_dt.astype(F32))[:, None]
    lr, li = lam_re.astype(F32), lam_im.astype(F32)
    mag = jnp.exp(lr * dt)
    a_re, a_im = mag * jnp.cos(li * dt), mag * jnp.sin(li * dt)
    den = lr * lr + li * li
    f_re = ((a_re - 1.0) * lr + a_im * li) / den
    f_im = (a_im * lr - (a_re - 1.0) * li) / den
    bb_re, bb_im = _cmul(f_re[..., None], f_im[..., None], b_re.astype(F32), b_im.astype(F32))
    return a_re, a_im, bb_re, bb_im


def _s5_combine(e1, e2):
    a1r, a1i, h1r, h1i = e1
    a2r, a2i, h2r, h2i = e2
    ar, ai = _cmul(a2r, a2i, a1r, a1i)
    hr, hi = _cmul(a2r, a2i, h1r, h1i)
    return ar, ai, hr + h2r, hi + h2i


def _s5_scan(u, a_re, a_im, bb_re, bb_im, c_re, c_im, h0_re, h0_im, reverse):
    bu_re = jnp.einsum('blgh,gph->blgp', u, bb_re)
    bu_im = jnp.einsum('blgh,gph->blgp', u, bb_im)
    pr, pi, hr, hi = lax.associative_scan(
        _s5_combine,
        (jnp.broadcast_to(a_re, bu_re.shape), jnp.broadcast_to(a_im, bu_re.shape), bu_re, bu_im),
        reverse=reverse, axis=1)
    cr, ci = _cmul(pr, pi, h0_re[:, None], h0_im[:, None])
    hr, hi = hr + cr, hi + ci
    y = (jnp.einsum('ghp,blgp->blgh', c_re.astype(F32), hr)
         - jnp.einsum('ghp,blgp->blgh', c_im.astype(F32), hi))
    end = 0 if reverse else -1
    return y, hr[:, end], hi[:, end]


def _s5_mixer(u_x, u_c, lam_re, lam_im, log_dt, b_re, b_im, c_re, c_im, d_skip, glu_w, ctx_out):
    def groups(u):
        return u.astype(F32).reshape(u.shape[0], u.shape[1], S5_GROUPS, S5_GROUP)

    ux, uc = groups(u_x), groups(u_c)
    d = d_skip.astype(F32).reshape(S5_GROUPS, S5_GROUP)
    y_x, y_c = d * ux, d * uc
    zeros = jnp.zeros((u_c.shape[0], S5_GROUPS, S5_STATE), F32)
    for direction in range(2):
        rev = direction == 1
        a_re, a_im, bb_re, bb_im = _s5_discretize(
            lam_re[direction], lam_im[direction], log_dt[direction], b_re[direction], b_im[direction])
        yc, hc_re, hc_im = _s5_scan(uc, a_re, a_im, bb_re, bb_im, c_re[direction], c_im[direction],
                                    zeros, zeros, rev)
        yx, _, _ = _s5_scan(ux, a_re, a_im, bb_re, bb_im, c_re[direction], c_im[direction],
                            hc_re, hc_im, rev)
        y_x, y_c = y_x + yx, y_c + yc

    def glu(y, like):
        z = jax.nn.gelu(y.reshape(like.shape[0], like.shape[1], S5_WIDTH)).astype(like.dtype) @ glu_w
        return z[..., :S5_WIDTH] * jax.nn.sigmoid(z[..., S5_WIDTH:])

    return glu(y_x, u_x), (glu(y_c, u_c) if ctx_out else None)


def _axial_rope_tables(seq_len):
    rows = seq_len // GRID_W
    row = jnp.repeat(jnp.arange(rows, dtype=F32), GRID_W)
    col = jnp.tile(jnp.arange(GRID_W, dtype=F32), rows)
    inv = ROPE_BASE ** (-jnp.arange(ROPE_FREQS, dtype=F32) / ROPE_FREQS)
    ang = jnp.concatenate([row[:, None] * inv, col[:, None] * inv], axis=-1)
    return jnp.cos(ang)[None, :, None, :], jnp.sin(ang)[None, :, None, :]


def _rope(x, cos, sin):
    half = MLA_ROPE // 2
    xr = x[..., MLA_NOPE:].astype(F32)
    r1, r2 = xr[..., :half], xr[..., half:]
    rot = jnp.concatenate([r1 * cos - r2 * sin, r1 * sin + r2 * cos], axis=-1).astype(x.dtype)
    return jnp.concatenate([x[..., :MLA_NOPE], rot], axis=-1)


def _mla_project(cq, ckv, k_rope, q_norm_w, kv_norm_w, w_uq, w_ukv, q_gain, k_gain):
    b, l = cq.shape[:2]
    q = (_rms(cq, q_norm_w) @ w_uq).reshape(b, l, MLA_HEADS, MLA_DH)
    kv = (_rms(ckv, kv_norm_w) @ w_ukv).reshape(b, l, MLA_HEADS, MLA_NOPE + MLA_V)
    k_r = jnp.broadcast_to(k_rope[:, :, None, :], (b, l, MLA_HEADS, MLA_ROPE))
    k = jnp.concatenate([kv[..., :MLA_NOPE], k_r], axis=-1)
    return _rms(q, q_gain), _rms(k, k_gain), kv[..., MLA_NOPE:]


def _softmax_attend(q, k, v):
    s = jnp.einsum('bqhd,bkhd->bhqk', q, k).astype(F32) * (MLA_DH ** -0.5)
    p = jax.nn.softmax(s, axis=-1).astype(v.dtype)
    return jnp.einsum('bhqk,bkhd->bqhd', p, v)


def _blocked_attention(q, k, v):
    b, l = q.shape[:2]
    nb = l // Q_BLOCK
    qb = jnp.moveaxis(q.reshape(b, nb, Q_BLOCK, MLA_HEADS, MLA_DH), 1, 0)
    o = lax.map(lambda blk: _softmax_attend(blk, k, v), qb)
    return jnp.moveaxis(o, 0, 1).reshape(b, l, MLA_WIDTH)


def _mla_mixer(cq_x, ckv_x, kr_x, cq_c, ckv_c, kr_c, q_norm_w, kv_norm_w, w_uq, w_ukv,
               q_gain, k_gain, cos, sin, ctx_out):
    qx, kx, vx = _mla_project(cq_x, ckv_x, kr_x, q_norm_w, kv_norm_w, w_uq, w_ukv, q_gain, k_gain)
    qx, kx = _rope(qx, cos, sin), _rope(kx, cos, sin)
    qc, kc, vc = _mla_project(cq_c, ckv_c, kr_c, q_norm_w, kv_norm_w, w_uq, w_ukv, q_gain, k_gain)
    k_all = jnp.concatenate([kx, kc], axis=1)
    v_all = jnp.concatenate([vx, vc], axis=1)
    o_x = _blocked_attention(qx, k_all, v_all)
    o_c = _softmax_attend(qc, kc, vc).reshape(qc.shape[0], qc.shape[1], MLA_WIDTH) if ctx_out else None
    return o_x, o_c


def _short_conv(x, w):
    pad = DN_CONV // 2
    return lax.conv_general_dilated(
        x, w[:, None, :].astype(x.dtype), window_strides=(1,), padding=[(pad, pad)],
        dimension_numbers=("NWC", "WIO", "NWC"), feature_group_count=x.shape[-1])


def _gated_delta_chunked(q, k, v, g, beta, s0):
    b, l, h, dk = q.shape
    n = l // DN_CHUNK

    def to_chunks(t):
        return jnp.moveaxis(t.astype(F32).reshape(b, n, DN_CHUNK, h, -1), 3, 1)

    qc = to_chunks(q) * (dk ** -0.5)
    kc, vc = to_chunks(k), to_chunks(v)
    gcum = jnp.cumsum(to_chunks(g[..., None])[..., 0], axis=-1)
    bc = to_chunks(beta[..., None])[..., 0]
    idx = jnp.arange(DN_CHUNK)
    incl = idx[:, None] >= idx[None, :]
    strict = idx[:, None] > idx[None, :]
    decay = jnp.exp(jnp.where(incl, gcum[..., :, None] - gcum[..., None, :], -jnp.inf))
    kb = kc * bc[..., None]
    a_mat = jnp.where(strict, jnp.einsum('bhncd,bhnsd->bhncs', kb, kc) * decay, 0.0)
    eye = jnp.eye(DN_CHUNK, dtype=F32)
    t_mat = lax.linalg.triangular_solve(a_mat + eye, jnp.broadcast_to(eye, a_mat.shape),
                                        left_side=True, lower=True)
    w_v = t_mat @ (vc * bc[..., None])
    w_k = t_mat @ (kb * jnp.exp(gcum)[..., None])
    attn = jnp.where(incl, jnp.einsum('bhncd,bhnsd->bhncs', qc, kc) * decay, 0.0)
    q_dec = qc * jnp.exp(gcum)[..., None]
    g_last = gcum[..., -1]
    k_dec = kc * jnp.exp(g_last[..., None] - gcum)[..., None]

    def step(state, xs):
        wv, wk, at, qd, kd, gl = xs
        v_new = wv - wk @ state
        o = qd @ state + at @ v_new
        state = state * jnp.exp(gl)[..., None, None] + jnp.swapaxes(kd, -1, -2) @ v_new
        return state, o

    xs = tuple(jnp.moveaxis(t, 2, 0) for t in (w_v, w_k, attn, q_dec, k_dec, g_last))
    s_fin, o = lax.scan(step, s0.astype(F32), xs)
    o = jnp.moveaxis(o, 0, 2).transpose(0, 2, 3, 1, 4).reshape(b, l, h, v.shape[-1])
    return o, s_fin


def _dn_mixer(qkv_x, qkv_c, gt_x, gt_c, ba_x, ba_c, conv_w, a_log, dt_bias, norm_w, ctx_out):
    def prep(qkv, ba):
        b, l = qkv.shape[:2]
        y = jax.nn.silu(_short_conv(qkv, conv_w))
        qk_w = DN_HEADS * DN_DK
        q = _l2norm(y[..., :qk_w].reshape(b, l, DN_HEADS, DN_DK))
        k = _l2norm(y[..., qk_w:2 * qk_w].reshape(b, l, DN_HEADS, DN_DK))
        v = y[..., 2 * qk_w:].reshape(b, l, DN_HEADS, DN_DV)
        ba = ba.astype(F32).reshape(b, l, 2, 2, DN_HEADS)
        beta = jax.nn.sigmoid(ba[:, :, 0])
        g = -jnp.exp(a_log.astype(F32)) * jax.nn.softplus(ba[:, :, 1] + dt_bias.astype(F32))
        return q, k, v, g, beta

    qx, kx, vx, gx, bx = prep(qkv_x, ba_x)
    qc, kc, vc, gc, bc = prep(qkv_c, ba_c)
    s0 = jnp.zeros((qkv_c.shape[0], DN_HEADS, DN_DK, DN_DV), F32)
    o_x, o_c = 0.0, 0.0
    for d in range(2):
        flip = (lambda t: jnp.flip(t, axis=1)) if d == 1 else (lambda t: t)
        oc, s_ctx = _gated_delta_chunked(flip(qc), flip(kc), flip(vc), flip(gc[:, :, d]), flip(bc[:, :, d]), s0)
        ox, _ = _gated_delta_chunked(flip(qx), flip(kx), flip(vx), flip(gx[:, :, d]), flip(bx[:, :, d]), s_ctx)
        o_x, o_c = o_x + flip(ox), o_c + flip(oc)

    def out(o, gt):
        b, l = gt.shape[:2]
        gate = jax.nn.silu(gt.reshape(b, l, DN_HEADS, DN_DV).astype(F32))
        return (_rms(o, norm_w) * gate).reshape(b, l, DN_WIDTH).astype(gt.dtype)

    return out(o_x, gt_x), (out(o_c, gt_c) if ctx_out else None)


def _sq_relu_mlp(h, w1, w2):
    return jnp.square(jax.nn.relu(h @ w1)) @ w2


def setup_inputs(seed: int = 0) -> dict:
    key = jax.random.key(seed)
    ks = iter(jax.random.split(key, 40))

    def nrm(shape, scale):
        return scale * jax.random.normal(next(ks), shape, F32)

    def gain(shape):
        return 1.0 + 0.02 * jax.random.normal(next(ks), shape, F32)

    dirs = (DEPTH, 2)
    state_idx = jnp.arange(S5_STATE, dtype=F32)
    dn_dt = jnp.exp(jax.random.uniform(next(ks), dirs + (DN_HEADS,), F32, math.log(1e-3), math.log(1e-1)))
    return {
        "x": nrm((BATCH, SEQ, D_MODEL), 1.0),
        "c": nrm((BATCH, D_MODEL), 1.0),
        "ctx": nrm((BATCH, CTX_LEN, D_MODEL), 1.0),
        "c_ctx": nrm((D_MODEL,), 1.0),
        "w_ada": nrm((DEPTH, D_MODEL, 6 * D_MODEL), 0.5 * D_MODEL ** -0.5),
        "b_ada": nrm((DEPTH, 6 * D_MODEL), 0.02),
        "norm1_w": gain((DEPTH, D_MODEL)),
        "w_in": nrm((DEPTH, D_MODEL, IN_WIDTH), D_MODEL ** -0.5),
        "s5_lambda_re": -0.5 + nrm(dirs + (S5_GROUPS, S5_STATE), 0.01),
        "s5_lambda_im": math.pi * state_idx + nrm(dirs + (S5_GROUPS, S5_STATE), 0.01),
        "s5_log_dt": jax.random.uniform(next(ks), dirs + (S5_GROUPS,), F32, math.log(1e-3), math.log(1e-1)),
        "s5_b_re": nrm(dirs + (S5_GROUPS, S5_STATE, S5_GROUP), S5_GROUP ** -0.5),
        "s5_b_im": nrm(dirs + (S5_GROUPS, S5_STATE, S5_GROUP), S5_GROUP ** -0.5),
        "s5_c_re": nrm(dirs + (S5_GROUPS, S5_GROUP, S5_STATE), S5_STATE ** -0.5),
        "s5_c_im": nrm(dirs + (S5_GROUPS, S5_GROUP, S5_STATE), S5_STATE ** -0.5),
        "s5_d": nrm((DEPTH, S5_WIDTH), 1.0),
        "s5_glu_w": nrm((DEPTH, S5_WIDTH, 2 * S5_WIDTH), S5_WIDTH ** -0.5),
        "mla_q_norm_w": gain((DEPTH, MLA_Q_RANK)),
        "mla_kv_norm_w": gain((DEPTH, MLA_KV_RANK)),
        "mla_w_uq": nrm((DEPTH, MLA_Q_RANK, MLA_HEADS * MLA_DH), MLA_Q_RANK ** -0.5),
        "mla_w_ukv": nrm((DEPTH, MLA_KV_RANK, MLA_HEADS * (MLA_NOPE + MLA_V)), MLA_KV_RANK ** -0.5),
        "mla_q_gain": gain((DEPTH, MLA_DH)),
        "mla_k_gain": gain((DEPTH, MLA_DH)),
        "dn_conv_w": nrm((DEPTH, DN_CONV, DN_QKV), DN_CONV ** -0.5),
        "dn_a_log": jnp.log(jax.random.uniform(next(ks), dirs + (DN_HEADS,), F32, 1.0, 16.0)),
        "dn_dt_bias": dn_dt + jnp.log(-jnp.expm1(-dn_dt)),
        "dn_norm_w": gain((DEPTH, DN_DV)),
        "w_out": nrm((DEPTH, D_MIX, D_MODEL), D_MIX ** -0.5),
        "norm2_w": gain((DEPTH, D_MODEL)),
        "w_ff1": nrm((DEPTH, D_MODEL, D_FF), D_MODEL ** -0.5),
        "w_ff2": nrm((DEPTH, D_FF, D_MODEL), D_FF ** -0.5),
    }


def reference(x, c, ctx, c_ctx, w_ada, b_ada, norm1_w, w_in, s5_lambda_re, s5_lambda_im, s5_log_dt,
              s5_b_re, s5_b_im, s5_c_re, s5_c_im, s5_d, s5_glu_w, mla_q_norm_w, mla_kv_norm_w,
              mla_w_uq, mla_w_ukv, mla_q_gain, mla_k_gain, dn_conv_w, dn_a_log, dn_dt_bias, dn_norm_w,
              w_out, norm2_w, w_ff1, w_ff2):
    cos, sin = _axial_rope_tables(x.shape[1])
    cx = ctx
    sc = jax.nn.silu(c)
    scc = jax.nn.silu(c_ctx)[None]
    for l in range(DEPTH):
        ctx_out = l < DEPTH - 1
        mx = (sc @ w_ada[l] + b_ada[l]).reshape(sc.shape[0], 6, D_MODEL)
        mc = (scc @ w_ada[l] + b_ada[l]).reshape(1, 6, D_MODEL)
        zx = _modulate(x, norm1_w[l], mx[:, 0, None], mx[:, 1, None]) @ w_in[l]
        zc = _modulate(cx, norm1_w[l], mc[:, 0, None], mc[:, 1, None]) @ w_in[l]
        u_x, cq_x, ckv_x, kr_x, qkv_x, gt_x, ba_x = _split_in(zx)
        u_c, cq_c, ckv_c, kr_c, qkv_c, gt_c, ba_c = _split_in(zc)
        s5_x, s5_c = _s5_mixer(u_x, u_c, s5_lambda_re[l], s5_lambda_im[l], s5_log_dt[l], s5_b_re[l],
                               s5_b_im[l], s5_c_re[l], s5_c_im[l], s5_d[l], s5_glu_w[l], ctx_out)
        mla_x, mla_c = _mla_mixer(cq_x, ckv_x, kr_x, cq_c, ckv_c, kr_c, mla_q_norm_w[l], mla_kv_norm_w[l],
                                  mla_w_uq[l], mla_w_ukv[l], mla_q_gain[l], mla_k_gain[l], cos, sin, ctx_out)
        dn_x, dn_c = _dn_mixer(qkv_x, qkv_c, gt_x, gt_c, ba_x, ba_c, dn_conv_w[l], dn_a_log[l],
                               dn_dt_bias[l], dn_norm_w[l], ctx_out)
        x = x + mx[:, 2, None] * (jnp.concatenate([s5_x, mla_x, dn_x], axis=-1) @ w_out[l])
        x = x + mx[:, 5, None] * _sq_relu_mlp(
            _modulate(x, norm2_w[l], mx[:, 3, None], mx[:, 4, None]), w_ff1[l], w_ff2[l])
        if ctx_out:
            cx = cx + mc[:, 2, None] * (jnp.concatenate([s5_c, mla_c, dn_c], axis=-1) @ w_out[l])
            cx = cx + mc[:, 5, None] * _sq_relu_mlp(
                _modulate(cx, norm2_w[l], mc[:, 3, None], mc[:, 4, None]), w_ff1[l], w_ff2[l])
    return x
```

```cpp
#include <hip/hip_runtime.h>
#include <hip/hip_cooperative_groups.h>
#include <cstdio>
#include <cstdint>
namespace cg = cooperative_groups;

typedef unsigned short bf16_t;
typedef short bf16x8 __attribute__((ext_vector_type(8)));
typedef float f32x4 __attribute__((ext_vector_type(4)));
typedef float f32x16 __attribute__((ext_vector_type(16)));
typedef unsigned u32x4 __attribute__((ext_vector_type(4)));

#define DEV __device__ __forceinline__
#define NLAT 16384
#define NROWS 17408
#define ZW 1712
#define ZS 1792
#define LDS_BYTES 65536
#define EPS 1e-6f
#define REPQ (-1)
#define DIS_DN 0
#define DIS_ATT 0
#define DIS_S5 0

struct P {
  const float *x, *c, *ctx, *c_ctx, *w_ada, *b_ada, *norm1_w, *w_in, *lam_re, *lam_im, *log_dt, *b_re, *b_im, *c_re, *c_im,
      *s5_d, *glu_w, *qn_w, *kvn_w, *w_uq, *w_ukv, *q_gain, *k_gain, *conv_w, *a_log, *dt_bias, *dn_norm_w, *w_out, *norm2_w, *w_ff1, *w_ff2;
  float* out;
  bf16_t *wt_in, *wt_out, *wt_ff1, *wt_ff2, *wt_uq, *wt_ukv, *wt_glu;
  float *mods, *rope, *xc, *Z, *E, *os, *gl;
  bf16_t *xn, *Kb, *Vt, *H, *dnop, *ys;
  unsigned* ctr;
  u32x4* fill_begin; size_t fill_n;
};

DEV int otid() { int t = threadIdx.x; asm volatile("" : "+v"(t)); return t; }
DEV float wave_sum(float v) {
#pragma unroll
  for (int o = 32; o; o >>= 1) v += __shfl_xor(v, o);
  return v;
}
typedef float f32x2 __attribute__((ext_vector_type(2)));
typedef __bf16 bf16x2_t __attribute__((ext_vector_type(2)));
DEV unsigned pk2(float lo, float hi) { f32x2 v = {lo, hi}; bf16x2_t b = __builtin_convertvector(v, bf16x2_t); return __builtin_bit_cast(unsigned, b); }
DEV bf16_t f2bf(float f) { return (bf16_t)(pk2(f, 0.f) & 0xffffu); }
DEV float bf2f(bf16_t b) { return __uint_as_float(((unsigned)b) << 16); }
DEV float sigmoidf_(float x) { return 1.f / (1.f + __expf(-x)); }
DEV float siluf_(float x) { return x / (1.f + __expf(-x)); }
DEV float geluf_(float x) { float u = 0.7978845608028654f * (x + 0.044715f * x * x * x); return x / (1.f + __expf(-2.f * u)); }
DEV f32x16 mfma32(bf16x8 a, bf16x8 b, f32x16 c) { return __builtin_amdgcn_mfma_f32_32x32x16_bf16(a, b, c, 0, 0, 0); }
DEV f32x4 mfma16(bf16x8 a, bf16x8 b, f32x4 c) { return __builtin_amdgcn_mfma_f32_16x16x32_bf16(a, b, c, 0, 0, 0); }
DEV bf16x8 pack8(float a0, float a1, float a2, float a3, float a4, float a5, float a6, float a7) {
  union { unsigned u[4]; bf16x8 v; } t;
  t.u[0] = pk2(a0, a1); t.u[1] = pk2(a2, a3); t.u[2] = pk2(a4, a5); t.u[3] = pk2(a6, a7);
  return t.v;
}
DEV int swap23(int d) { return (d & ~12) | ((d & 4) << 1) | ((d & 8) >> 1); }
DEV int kperm(int p) { return (p & 0x23) | ((p & 0x18) >> 1) | ((p & 0x04) << 2); }
DEV int kpinv(int x) { return (x & 0x23) | ((x & 0x0C) << 1) | ((x & 0x10) >> 2); }

DEV void chk(const P& p, int stage, float v) {
#ifdef DBGCHK
  if (!(fabsf(v) < 1e30f)) atomicMax(p.ctr + 8, (unsigned)(1000 - stage));
#endif
}
DEV const float* xrow_src(const P& p, bool from_input, int r) {
  if (r < NLAT) return (from_input ? p.x : p.out) + (size_t)r * 1024;
  return (from_input ? p.ctx : p.xc) + (size_t)(r - NLAT) * 1024;
}
DEV float* xrow_dst(const P& p, int r) { return r < NLAT ? p.out + (size_t)r * 1024 : p.xc + (size_t)(r - NLAT) * 1024; }

__device__ void phase0(const P& p, char* lds) {
  float* sc = (float*)lds;
  float* red = sc + 5120;
  const int tid = otid();
  bool loaded = false;
  for (int t = blockIdx.x; t < 385; t += gridDim.x) {
    if (t == 384) {
      for (int i = tid; i < 512; i += 256) {
        int pos = i >> 3, f = i & 7;
        float inv = powf(10000.f, -(float)f / 8.f);
        float ang = (float)pos * inv;
        p.rope[i * 2] = cosf(ang); p.rope[i * 2 + 1] = sinf(ang);
      }
      continue;
    }
    if (!loaded) {
      for (int i = tid; i < 5120; i += 256) { int m = i >> 10, k = i & 1023; float v = m < 4 ? p.c[m * 1024 + k] : p.c_ctx[k]; sc[i] = v / (1.f + expf(-v)); }
      __syncthreads(); loaded = true;
    }
    const int l = t / 96, j0 = (t % 96) * 64, col = tid & 63, kq = tid >> 6;
    const float* w = p.w_ada + (size_t)l * 1024 * 6144 + j0 + col;
    float a0 = 0, a1 = 0, a2 = 0, a3 = 0, a4 = 0;
    for (int k = kq * 256; k < kq * 256 + 256; ++k) {
      float wv = w[(size_t)k * 6144];
      a0 += sc[k] * wv; a1 += sc[1024 + k] * wv; a2 += sc[2048 + k] * wv; a3 += sc[3072 + k] * wv; a4 += sc[4096 + k] * wv;
    }
    red[(kq * 5 + 0) * 64 + col] = a0; red[(kq * 5 + 1) * 64 + col] = a1; red[(kq * 5 + 2) * 64 + col] = a2;
    red[(kq * 5 + 3) * 64 + col] = a3; red[(kq * 5 + 4) * 64 + col] = a4;
    __syncthreads();
    for (int i = tid; i < 320; i += 256) {
      int m = i >> 6, cc = i & 63;
      float s = red[(0 * 5 + m) * 64 + cc] + red[(1 * 5 + m) * 64 + cc] + red[(2 * 5 + m) * 64 + cc] + red[(3 * 5 + m) * 64 + cc];
      p.mods[(size_t)(l * 5 + m) * 6144 + j0 + cc] = s + p.b_ada[l * 6144 + j0 + cc];
    }
    __syncthreads();
  }
}

__device__ void conv_tile(const float* src, int K, int N, bf16_t* dst, int kt, int nt, float* tile) {
  const int tid = otid();
  const int k0 = kt * 64, n0 = nt * 64;
#pragma unroll
  for (int i = 0; i < 4; ++i) {
    int r = (tid >> 4) + i * 16, c4 = (tid & 15) * 4;
    float4 v = make_float4(0.f, 0.f, 0.f, 0.f);
    if (n0 + c4 < N) v = *(const float4*)(src + (size_t)(k0 + r) * N + n0 + c4);
    tile[r * 65 + c4 + 0] = v.x; tile[r * 65 + c4 + 1] = v.y; tile[r * 65 + c4 + 2] = v.z; tile[r * 65 + c4 + 3] = v.w;
  }
  __syncthreads();
  const int n = tid >> 2, kq = tid & 3;
  unsigned pk[8];
#pragma unroll
  for (int i = 0; i < 8; ++i) pk[i] = pk2(tile[(kq * 16 + 2 * i) * 65 + n], tile[(kq * 16 + 2 * i + 1) * 65 + n]);
  uint4* d = (uint4*)(dst + (size_t)(n0 + n) * K + k0 + kq * 16);
  d[0] = make_uint4(pk[0], pk[1], pk[2], pk[3]); d[1] = make_uint4(pk[4], pk[5], pk[6], pk[7]);
  __syncthreads();
}

__device__ void norm_task(const P& p, int l, int which, int task) {
  const int tid = otid(), wid = tid >> 6, lane = tid & 63;
  const float* nw = (which ? p.norm2_w : p.norm1_w) + l * 1024;
  const bool from_input = (l == 0 && which == 0);
#pragma unroll
  for (int rr = 0; rr < 4; ++rr) {
    const int r = task * 16 + wid * 4 + rr;
    const float* xr = xrow_src(p, from_input, r);
    const int m = r < NLAT ? (r >> 12) : 4;
    const float* sh = p.mods + (size_t)((l * 5 + m) * 6 + (which ? 3 : 0)) * 1024;
    const float* scl = sh + 1024;
    float4 v[4]; float ss = 0.f;
#pragma unroll
    for (int i = 0; i < 4; ++i) { v[i] = *(const float4*)(xr + i * 256 + lane * 4); ss += v[i].x * v[i].x + v[i].y * v[i].y + v[i].z * v[i].z + v[i].w * v[i].w; }
    ss = wave_sum(ss);
    const float rinv = rsqrtf(ss * (1.f / 1024.f) + EPS);
#pragma unroll
    for (int i = 0; i < 4; ++i) {
      const int c = i * 256 + lane * 4;
      float4 w4 = *(const float4*)(nw + c), s4 = *(const float4*)(scl + c), h4 = *(const float4*)(sh + c);
      float y0 = v[i].x * rinv * w4.x * (1.f + s4.x) + h4.x, y1 = v[i].y * rinv * w4.y * (1.f + s4.y) + h4.y;
      float y2 = v[i].z * rinv * w4.z * (1.f + s4.z) + h4.z, y3 = v[i].w * rinv * w4.w * (1.f + s4.w) + h4.w;
      chk(p, 10, s4.x + h4.x + w4.x); chk(p, which ? 110 : 20, y0 + y1 + y2 + y3);
      *(uint2*)(p.xn + (size_t)r * 1024 + c) = make_uint2(pk2(y0, y1), pk2(y2, y3));
    }
  }
}

template <int EPI>
__device__ void gemm_phase(const P& p, int l, const bf16_t* A, int lda, const bf16_t* Bt, int ldb, int Mt, int Nt, int K, int gi, char* lds) {
  const int tid = otid(), lane = tid & 63, wid = tid >> 6, wm = wid >> 1, wn = wid & 1;
  char* sA = lds; char* sB = lds + 128 * 144;
  const int srow = tid >> 3, sch = tid & 7;
  const bool xcdmap = (Nt == 8) && ((gridDim.x & 7) == 0);
  const int nper = xcdmap ? (Mt >> 3) * Nt : Mt * Nt;
  for (int v = xcdmap ? (blockIdx.x >> 3) : blockIdx.x; v < nper; v += xcdmap ? (gridDim.x >> 3) : gridDim.x) {
    const int mt = xcdmap ? (v / Nt) * 8 + (blockIdx.x & 7) : v / Nt, nt = v % Nt, m0 = mt * 128, n0 = nt * 128;
    f32x16 acc[2][2];
#pragma unroll
    for (int i = 0; i < 2; ++i)
#pragma unroll
      for (int j = 0; j < 2; ++j)
#pragma unroll
        for (int e = 0; e < 16; ++e) acc[i][j][e] = 0.f;
    const bf16_t* Ap = A + (size_t)(m0 + srow) * lda + sch * 8;
    const bf16_t* Bp = Bt + (size_t)(n0 + srow) * ldb + sch * 8;
    u32x4 ra[4], rb[4];
#pragma unroll
    for (int i = 0; i < 4; ++i) { ra[i] = *(const u32x4*)(Ap + (size_t)i * 32 * lda); rb[i] = *(const u32x4*)(Bp + (size_t)i * 32 * ldb); }
    const int nk = K >> 6;
#pragma unroll 1
    for (int kt = 0; kt < nk; ++kt) {
      __syncthreads();
#pragma unroll
      for (int i = 0; i < 4; ++i) {
        *(u32x4*)(sA + (srow + i * 32) * 144 + sch * 16) = ra[i];
        *(u32x4*)(sB + (srow + i * 32) * 144 + sch * 16) = rb[i];
      }
      __syncthreads();
      if (kt + 1 < nk) {
        const int k0 = (kt + 1) * 64;
#pragma unroll
        for (int i = 0; i < 4; ++i) { ra[i] = *(const u32x4*)(Ap + (size_t)i * 32 * lda + k0); rb[i] = *(const u32x4*)(Bp + (size_t)i * 32 * ldb + k0); }
      }
#pragma unroll
      for (int ks = 0; ks < 4; ++ks) {
        bf16x8 a[2], b[2];
#pragma unroll
        for (int i = 0; i < 2; ++i) a[i] = *(const bf16x8*)(sA + (wm * 64 + i * 32 + (lane & 31)) * 144 + (ks * 16 + (lane >> 5) * 8) * 2);
#pragma unroll
        for (int j = 0; j < 2; ++j) b[j] = *(const bf16x8*)(sB + (wn * 64 + j * 32 + (lane & 31)) * 144 + (ks * 16 + (lane >> 5) * 8) * 2);
#pragma unroll
        for (int i = 0; i < 2; ++i)
#pragma unroll
          for (int j = 0; j < 2; ++j) acc[i][j] = mfma32(a[i], b[j], acc[i][j]);
      }
    }
    __syncthreads();
    float* sC = (float*)lds;
#pragma unroll
    for (int i = 0; i < 2; ++i)
#pragma unroll
      for (int j = 0; j < 2; ++j)
#pragma unroll
        for (int e = 0; e < 16; ++e)
          sC[(wm * 64 + i * 32 + 8 * (e >> 2) + 4 * (lane >> 5) + (e & 3)) * 128 + wn * 64 + j * 32 + (lane & 31)] = acc[i][j][e];
    __syncthreads();
#pragma unroll 2
    for (int it = 0; it < 16; ++it) {
      const int idx = tid + it * 256, r = idx >> 5, c4 = (idx & 31) * 4;
      const f32x4 v = *(const f32x4*)(sC + r * 128 + c4);
      const int row = m0 + r, col = n0 + c4;
      chk(p, EPI == 0 ? 30 : (EPI == 2 ? 120 : (gi == 2 ? 100 : 130)), v[0] + v[1] + v[2] + v[3]);
      if (EPI == 0) { if (col < ZW) *(f32x4*)(p.Z + (size_t)row * ZS + col) = v; }
      else if (EPI == 1) {
        const int m = row < NLAT ? (row >> 12) : 4;
        const f32x4 g = *(const f32x4*)(p.mods + (size_t)((l * 5 + m) * 6 + gi) * 1024 + col);
        const f32x4 xo = *(const f32x4*)(xrow_src(p, (l == 0 && gi == 2), row) + col);
        f32x4 xr = xo + g * v;
#ifdef SANITIZE
#pragma unroll
        for (int q = 0; q < 4; ++q) if (!(fabsf(xr[q]) < 1e30f)) xr[q] = 0.f;
#endif
        *(f32x4*)(xrow_dst(p, row) + col) = xr;
      } else {
        const float r0 = fmaxf(v[0], 0.f), r1 = fmaxf(v[1], 0.f), r2 = fmaxf(v[2], 0.f), r3 = fmaxf(v[3], 0.f);
        *(uint2*)(p.H + (size_t)row * 4096 + col) = make_uint2(pk2(r0 * r0, r1 * r1), pk2(r2 * r2, r3 * r3));
      }
    }
  }
}

struct S5D { float ar, ai; float bbr[16], bbi[16]; };
DEV void s5_disc(const P& p, int l, int dir, int g, int lane, S5D& d) {
  const int idx = (l * 2 + dir) * 16 + g;
  const float lr = p.lam_re[idx * 64 + lane], li = p.lam_im[idx * 64 + lane];
  const float dt = expf(p.log_dt[idx]);
  const float mag = expf(lr * dt);
  float sn, cs; sincosf(li * dt, &sn, &cs);
  d.ar = mag * cs; d.ai = mag * sn;
  const float den = lr * lr + li * li;
  const float fr = ((d.ar - 1.f) * lr + d.ai * li) / den;
  const float fi = (d.ai * lr - (d.ar - 1.f) * li) / den;
  const float* br = p.b_re + (size_t)(idx * 64 + lane) * 16;
  const float* bi = p.b_im + (size_t)(idx * 64 + lane) * 16;
#pragma unroll
  for (int c = 0; c < 16; ++c) { float r = br[c], i = bi[c]; d.bbr[c] = fr * r - fi * i; d.bbi[c] = fr * i + fi * r; }
}

__device__ void s5p1_task(const P& p, int l, int task) {
  const int tid = otid(), lane = tid & 63, wid = __builtin_amdgcn_readfirstlane(tid >> 6);
  const int cq = task % 17, g = (task / 17) % 16, dir = (task / 272) % 2, b = task / 544;
  const int c = cq * 4 + wid;
  S5D d; s5_disc(p, l, dir, g, lane, d);
  float hr = 0.f, hi = 0.f;
  f32x4 ur[4];
  {
    const int pp = c * 64 + lane;
    const int row = pp < 256 ? NLAT + b * 256 + (dir ? 255 - pp : pp) : b * 4096 + (dir ? 4095 - (pp - 256) : pp - 256);
    const float* u = p.Z + (size_t)row * ZS + g * 16;
#pragma unroll
    for (int k = 0; k < 4; ++k) ur[k] = *(const f32x4*)(u + k * 4);
  }
#pragma unroll 4
  for (int i = 0; i < 64; ++i) {
    float bur = 0.f, bui = 0.f;
#pragma unroll
    for (int ch = 0; ch < 16; ++ch) {
      const float uv = __uint_as_float(__builtin_amdgcn_readlane(__float_as_uint(ur[ch >> 2][ch & 3]), i));
      bur += d.bbr[ch] * uv; bui += d.bbi[ch] * uv;
    }
    const float nr = d.ar * hr - d.ai * hi + bur, ni = d.ar * hi + d.ai * hr + bui;
    hr = nr; hi = ni;
  }
  chk(p, 50, hr + hi);
  *(float2*)(p.E + ((size_t)(((b * 2 + dir) * 16 + g) * 68 + c) * 64 + lane) * 2) = make_float2(hr, hi);
}

__device__ void s5p3_task(const P& p, int l, int task, char* lds) {
  const int tid = otid(), lane = tid & 63, wid = __builtin_amdgcn_readfirstlane(tid >> 6);
  const int b = task / 68, tc = task % 68;
  char* my = lds + wid * 12800;
  bf16_t* Hh = (bf16_t*)my; bf16_t* Hl = Hh + 16 * 136; float* Yacc = (float*)(my + 8704);
  const int rowbase = tc < 4 ? NLAT + b * 256 + tc * 64 : b * 4096 + (tc - 4) * 64;
  const int c15 = lane & 15, q4 = lane >> 4;
#pragma unroll 1
  for (int gi = 0; gi < 4; ++gi) {
    const int g = wid * 4 + gi;
    for (int e = lane; e < 1024; e += 64) { int tok = e >> 4, ch = e & 15; Yacc[e] = p.s5_d[l * 256 + g * 16 + ch] * p.Z[(size_t)(rowbase + tok) * ZS + g * 16 + ch]; }
    f32x4 ur[4];
    {
      const float* u = p.Z + (size_t)(rowbase + lane) * ZS + g * 16;
#pragma unroll
      for (int k = 0; k < 4; ++k) ur[k] = *(const f32x4*)(u + k * 4);
    }
#pragma unroll 1
    for (int dir = 0; dir < 2; ++dir) {
      S5D d; s5_disc(p, l, dir, g, lane, d);
      float pr = d.ar, pi = d.ai;
#pragma unroll
      for (int s = 0; s < 6; ++s) { float nr = pr * pr - pi * pi, ni = 2.f * pr * pi; pr = nr; pi = ni; }
      const int cidx = dir ? (tc < 4 ? 3 - tc : 71 - tc) : tc;
      float hr = 0.f, hi = 0.f;
      const float2* Eb = (const float2*)p.E + (size_t)(((b * 2 + dir) * 16 + g) * 68) * 64 + lane;
      {
        int cc = 0;
        for (; cc + 4 <= cidx; cc += 4) {
          const float2 e0 = Eb[cc * 64], e1 = Eb[(cc + 1) * 64], e2 = Eb[(cc + 2) * 64], e3 = Eb[(cc + 3) * 64];
          float nr = pr * hr - pi * hi + e0.x, ni = pr * hi + pi * hr + e0.y; hr = nr; hi = ni;
          nr = pr * hr - pi * hi + e1.x; ni = pr * hi + pi * hr + e1.y; hr = nr; hi = ni;
          nr = pr * hr - pi * hi + e2.x; ni = pr * hi + pi * hr + e2.y; hr = nr; hi = ni;
          nr = pr * hr - pi * hi + e3.x; ni = pr * hi + pi * hr + e3.y; hr = nr; hi = ni;
        }
        for (; cc < cidx; ++cc) { const float2 e = Eb[cc * 64]; const float nr = pr * hr - pi * hi + e.x, ni = pr * hi + pi * hr + e.y; hr = nr; hi = ni; }
      }
      const int idx = (l * 2 + dir) * 16 + g;
      bf16x8 Ch[4], Cl[4];
#pragma unroll
      for (int ks = 0; ks < 4; ++ks) {
        const float* sre = p.c_re + (size_t)(idx * 16 + c15) * 64 + ks * 16 + q4 * 4;
        const float* sim = p.c_im + (size_t)(idx * 16 + c15) * 64 + ks * 16 + q4 * 4;
        float v[8], lo[8];
#pragma unroll
        for (int j = 0; j < 8; ++j) { v[j] = (j & 1) ? -sim[j >> 1] : sre[j >> 1]; lo[j] = v[j] - bf2f(f2bf(v[j])); }
        Ch[ks] = pack8(v[0], v[1], v[2], v[3], v[4], v[5], v[6], v[7]);
        Cl[ks] = pack8(lo[0], lo[1], lo[2], lo[3], lo[4], lo[5], lo[6], lo[7]);
      }
#pragma unroll 1
      for (int sub = 0; sub < 4; ++sub) {
#pragma unroll 2
        for (int ii = 0; ii < 16; ++ii) {
          const int ip = sub * 16 + ii, tok = dir ? 63 - ip : ip;
          float bur = 0.f, bui = 0.f;
#pragma unroll
          for (int ch = 0; ch < 16; ++ch) {
            const float uv = __uint_as_float(__builtin_amdgcn_readlane(__float_as_uint(ur[ch >> 2][ch & 3]), tok));
            bur += d.bbr[ch] * uv; bui += d.bbi[ch] * uv;
          }
          const float nr = d.ar * hr - d.ai * hi + bur, ni = d.ar * hi + d.ai * hr + bui;
          hr = nr; hi = ni;
          const unsigned hpk = pk2(hr, hi);
          ((unsigned*)Hh)[ii * 68 + lane] = hpk;
          ((unsigned*)Hl)[ii * 68 + lane] = pk2(hr - __uint_as_float(hpk << 16), hi - __uint_as_float(hpk & 0xffff0000u));
        }
        __syncthreads();
        f32x4 ya = {0.f, 0.f, 0.f, 0.f};
#pragma unroll
        for (int ks = 0; ks < 4; ++ks) {
          bf16x8 ah = *(const bf16x8*)(Hh + c15 * 136 + ks * 32 + q4 * 8);
          bf16x8 al = *(const bf16x8*)(Hl + c15 * 136 + ks * 32 + q4 * 8);
          ya = mfma16(ah, Ch[ks], ya); ya = mfma16(al, Ch[ks], ya); ya = mfma16(ah, Cl[ks], ya);
        }
#pragma unroll
        for (int j = 0; j < 4; ++j) { const int ip = sub * 16 + q4 * 4 + j, tok = dir ? 63 - ip : ip; Yacc[tok * 16 + c15] += ya[j]; }
        __syncthreads();
      }
    }
    for (int e = lane; e < 1024; e += 64) { int tok = e >> 4, ch = e & 15; __builtin_nontemporal_store(f2bf(geluf_(Yacc[e])), &p.ys[(size_t)(rowbase + tok) * 256 + g * 16 + ch]); }
  }
  asm volatile("s_waitcnt vmcnt(0)" ::: "memory");
  __syncthreads();
  bf16x8 af[8];
  const bf16_t* arow = p.ys + (size_t)(rowbase + wid * 16 + c15) * 256 + q4 * 8;
#pragma unroll
  for (int ks = 0; ks < 8; ++ks) af[ks] = __builtin_nontemporal_load((const bf16x8*)(arow + ks * 32));
#pragma unroll 1
  for (int ct = 0; ct < 16; ++ct) {
    f32x4 a1 = {0.f, 0.f, 0.f, 0.f}, a2 = {0.f, 0.f, 0.f, 0.f};
    const bf16_t* w1 = p.wt_glu + (size_t)(ct * 16 + c15) * 256 + q4 * 8;
    const bf16_t* w2 = w1 + (size_t)256 * 256;
#pragma unroll
    for (int ks = 0; ks < 8; ++ks) {
      a1 = mfma16(af[ks], *(const bf16x8*)(w1 + ks * 32), a1);
      a2 = mfma16(af[ks], *(const bf16x8*)(w2 + ks * 32), a2);
    }
#pragma unroll
    for (int j = 0; j < 4; ++j) {
      const int tok = wid * 16 + q4 * 4 + j;
      chk(p, 80, a1[j] * sigmoidf_(a2[j]));
      p.xn[(size_t)(rowbase + tok) * 1024 + ct * 16 + c15] = DIS_S5 ? (bf16_t)0 : f2bf(a1[j] * sigmoidf_(a2[j]));
    }
  }
  __syncthreads();
}

__device__ void kv_task(const P& p, int l, int task, char* lds) {
  const int tid = otid(), lane = tid & 63, wid = __builtin_amdgcn_readfirstlane(tid >> 6);
  const int rb = task * 64 + wid * 16;
  char* my = lds + wid * 8192;
  bf16_t* Akv = (bf16_t*)my; float* krs = (float*)(my + 4352); float* kss = krs + 512;
  const float* kvnw = p.kvn_w + l * 128;
#pragma unroll 1
  for (int rr = 0; rr < 16; ++rr) {
    const float* z = p.Z + (size_t)(rb + rr) * ZS;
    float2 v = *(const float2*)(z + 512 + lane * 2);
    float ss = wave_sum(v.x * v.x + v.y * v.y);
    const float rinv = rsqrtf(ss * (1.f / 128.f) + EPS);
    float2 w2 = *(const float2*)(kvnw + lane * 2);
    *(unsigned*)(Akv + rr * 136 + lane * 2) = pk2(v.x * rinv * w2.x, v.y * rinv * w2.y);
    float kr = lane < 32 ? z[640 + lane] : 0.f;
    if (lane < 32) krs[rr * 32 + lane] = kr;
    float s2 = wave_sum(kr * kr);
    if (lane == 0) kss[rr] = s2;
  }
  __syncthreads();
  const int c = lane & 15, q = lane >> 4;
  int b, key0; bool lat;
  if (rb < NLAT) { b = rb >> 12; key0 = rb & 4095; lat = true; } else { int rc = rb - NLAT; b = rc >> 8; key0 = 4096 + (rc & 255); lat = false; }
  const float* kg = p.k_gain + l * 96;
#pragma unroll 1
  for (int h = 0; h < 8; ++h) {
    f32x4 acc[8];
#pragma unroll
    for (int ct = 0; ct < 8; ++ct) acc[ct] = (f32x4){0.f, 0.f, 0.f, 0.f};
#pragma unroll
    for (int ks = 0; ks < 4; ++ks) {
      bf16x8 a = *(const bf16x8*)(Akv + c * 136 + ks * 32 + q * 8);
#pragma unroll
      for (int ct = 0; ct < 8; ++ct) {
        bf16x8 bb = *(const bf16x8*)(p.wt_ukv + (size_t)(h * 128 + ct * 16 + c) * 128 + ks * 32 + q * 8);
        acc[ct] = mfma16(a, bb, acc[ct]);
      }
    }
#pragma unroll
    for (int j = 0; j < 4; ++j) {
      const int rr = q * 4 + j;
      float s = acc[0][j] * acc[0][j] + acc[1][j] * acc[1][j] + acc[2][j] * acc[2][j] + acc[3][j] * acc[3][j];
      s += __shfl_xor(s, 1); s += __shfl_xor(s, 2); s += __shfl_xor(s, 4); s += __shfl_xor(s, 8);
      s += kss[rr];
      const float rinv = rsqrtf(s * (1.f / 96.f) + EPS);
      const int key = key0 + rr;
      bf16_t* kd = p.Kb + ((size_t)(b * 8 + h) * 4352 + key) * 96;
#pragma unroll
      for (int ct = 0; ct < 4; ++ct) { const int dd = ct * 16 + c; kd[swap23(dd)] = f2bf(acc[ct][j] * rinv * kg[dd]); }
      float r1 = krs[rr * 32 + c] * rinv * kg[64 + c], r2 = krs[rr * 32 + 16 + c] * rinv * kg[80 + c];
      float o1 = r1, o2 = r2;
      if (lat) {
        const int pos = (c < 8) ? (key >> 6) : (key & 63);
        const float cs = p.rope[(pos * 8 + (c & 7)) * 2], sn = p.rope[(pos * 8 + (c & 7)) * 2 + 1];
        o1 = r1 * cs - r2 * sn; o2 = r1 * sn + r2 * cs;
      }
      chk(p, 40, o1 + o2 + rinv + acc[4][j] + acc[7][j]);
      kd[swap23(64 + c)] = f2bf(o1); kd[swap23(80 + c)] = f2bf(o2);
    }
    const int qs = ((q & 1) << 1) | (q >> 1);
#pragma unroll
    for (int ct = 4; ct < 8; ++ct) {
      const int dv = (ct - 4) * 16 + c;
      bf16_t* vd = p.Vt + ((size_t)(b * 8 + h) * 64 + dv) * 4352 + key0 + qs * 4;
      *(uint2*)vd = make_uint2(pk2(acc[ct][0], acc[ct][1]), pk2(acc[ct][2], acc[ct][3]));
    }
  }
  __syncthreads();
}

__device__ void attn_task(const P& p, int l, int task, char* lds) {
  const int tid = otid(), lane = tid & 63, wid = __builtin_amdgcn_readfirstlane(tid >> 6);
  int qt, h, b;
  if (task < 1024) { qt = task & 31; h = (task >> 5) & 7; b = task >> 8; } else { const int u = task - 1024; qt = 32 + (u & 1); h = (u >> 1) & 7; b = u >> 4; }
  const bool lat = qt < 32;
  const int rowq0 = lat ? b * 4096 + qt * 128 : NLAT + b * 256 + (qt - 32) * 128;
  const int l31 = lane & 31, hh = lane >> 5;
  bf16_t* cqn = (bf16_t*)lds;
  {
    const float* qnw = p.qn_w + l * 256;
    float4 w4 = *(const float4*)(qnw + lane * 4);
#pragma unroll 1
    for (int rr = 0; rr < 32; ++rr) {
      const float* z = p.Z + (size_t)(rowq0 + wid * 32 + rr) * ZS + 256;
      float4 v = *(const float4*)(z + lane * 4);
      float ss = wave_sum(v.x * v.x + v.y * v.y + v.z * v.z + v.w * v.w);
      const float rinv = rsqrtf(ss * (1.f / 256.f) + EPS);
      *(uint2*)(cqn + (wid * 32 + rr) * 256 + lane * 4) = make_uint2(pk2(v.x * rinv * w4.x, v.y * rinv * w4.y), pk2(v.z * rinv * w4.z, v.w * rinv * w4.w));
    }
  }
  __syncthreads();
  bf16x8 qf[6];
  {
    f32x16 qa[3];
#pragma unroll
    for (int bl = 0; bl < 3; ++bl)
#pragma unroll
      for (int e = 0; e < 16; ++e) qa[bl][e] = 0.f;
#pragma unroll 4
    for (int ks = 0; ks < 16; ++ks) {
      bf16x8 bq = *(const bf16x8*)(cqn + (wid * 32 + l31) * 256 + ks * 16 + hh * 8);
#pragma unroll
      for (int bl = 0; bl < 3; ++bl) {
        bf16x8 aw = *(const bf16x8*)(p.wt_uq + (size_t)(h * 96 + bl * 32 + l31) * 256 + ks * 16 + hh * 8);
        qa[bl] = mfma32(aw, bq, qa[bl]);
      }
    }
    float ss = 0.f;
#pragma unroll
    for (int bl = 0; bl < 3; ++bl)
#pragma unroll
      for (int e = 0; e < 16; ++e) ss += qa[bl][e] * qa[bl][e];
    ss += __shfl_xor(ss, 32);
    const float rinv = rsqrtf(ss * (1.f / 96.f) + EPS);
    const float* qg = p.q_gain + l * 96;
#pragma unroll
    for (int bl = 0; bl < 3; ++bl)
#pragma unroll
      for (int e = 0; e < 16; ++e) { const int dd = bl * 32 + 8 * (e >> 2) + 4 * hh + (e & 3); qa[bl][e] *= rinv * qg[dd]; }
    if (lat) {
      const int t = qt * 128 + wid * 32 + l31;
#pragma unroll
      for (int e = 0; e < 8; ++e) {
        const int pos = (e < 4) ? (t >> 6) : (t & 63);
        const int f = 4 * hh + (e & 3);
        const float cs = p.rope[(pos * 8 + f) * 2], sn = p.rope[(pos * 8 + f) * 2 + 1];
        const float r1 = qa[2][e], r2 = qa[2][e + 8];
        qa[2][e] = r1 * cs - r2 * sn; qa[2][e + 8] = r1 * sn + r2 * cs;
      }
    }
    const float sc = 0.10206207261596575f * 1.4426950408889634f;
#pragma unroll
    for (int bl = 0; bl < 3; ++bl)
#pragma unroll
      for (int s = 0; s < 2; ++s)
        qf[bl * 2 + s] = pack8(qa[bl][8 * s + 0] * sc, qa[bl][8 * s + 1] * sc, qa[bl][8 * s + 2] * sc, qa[bl][8 * s + 3] * sc,
                               qa[bl][8 * s + 4] * sc, qa[bl][8 * s + 5] * sc, qa[bl][8 * s + 6] * sc, qa[bl][8 * s + 7] * sc);
  }
  __syncthreads();
  const int nkt = lat ? 68 : 4, kbase = lat ? 0 : 4096;
  const bf16_t* Kg = p.Kb + (size_t)(b * 8 + h) * 4352 * 96;
  const bf16_t* Vg = p.Vt + (size_t)(b * 8 + h) * 64 * 4352;
  char* Ks = lds; char* Vs = lds + 2 * 13312;
  u32x4 rk0[3], rv0[2], rk1[3], rv1[2];
  auto gload = [&](int kt, u32x4 (&rk)[3], u32x4 (&rv)[2]) {
    const int key0 = kbase + kt * 64;
#pragma unroll
    for (int i = 0; i < 3; ++i) { const int idx = tid + i * 256, row = idx / 12, ch = idx % 12; rk[i] = *(const u32x4*)(Kg + (size_t)(key0 + row) * 96 + ch * 8); }
#pragma unroll
    for (int i = 0; i < 2; ++i) { const int idx = tid + i * 256, row = idx >> 3, ch = idx & 7; rv[i] = *(const u32x4*)(Vg + (size_t)row * 4352 + key0 + ch * 8); }
  };
  auto sstore = [&](int buf, const u32x4 (&rk)[3], const u32x4 (&rv)[2]) {
#pragma unroll
    for (int i = 0; i < 3; ++i) { const int idx = tid + i * 256, row = idx / 12, ch = idx % 12; *(u32x4*)(Ks + buf * 13312 + row * 208 + ch * 16) = rk[i]; }
#pragma unroll
    for (int i = 0; i < 2; ++i) { const int idx = tid + i * 256, row = idx >> 3, ch = idx & 7; *(u32x4*)(Vs + buf * 9216 + row * 144 + ch * 16) = rv[i]; }
  };
  f32x16 oacc[2];
#pragma unroll
  for (int bl = 0; bl < 2; ++bl)
#pragma unroll
    for (int e = 0; e < 16; ++e) oacc[bl][e] = 0.f;
  float mrun = -1e30f, lrun = 0.f;
  auto tile = [&](int buf) {
    const char* ksb = Ks + buf * 13312; const char* vsb = Vs + buf * 9216;
    f32x16 sa[2];
#pragma unroll
    for (int kb = 0; kb < 2; ++kb) {
#pragma unroll
      for (int e = 0; e < 16; ++e) sa[kb][e] = 0.f;
#pragma unroll
      for (int st = 0; st < 6; ++st) {
        bf16x8 ak = *(const bf16x8*)(ksb + (kb * 32 + l31) * 208 + (st * 16 + hh * 8) * 2);
        sa[kb] = mfma32(ak, qf[st], sa[kb]);
      }
    }
    float mx = sa[0][0];
#pragma unroll
    for (int kb = 0; kb < 2; ++kb)
#pragma unroll
      for (int e = 0; e < 16; ++e) mx = fmaxf(mx, sa[kb][e]);
    mx = fmaxf(mx, __shfl_xor(mx, 32));
    const float mnew = fmaxf(mrun, mx);
    const float alpha = __builtin_amdgcn_exp2f(mrun - mnew);
    mrun = mnew;
    float ps = 0.f;
#pragma unroll
    for (int kb = 0; kb < 2; ++kb)
#pragma unroll
      for (int e = 0; e < 16; ++e) { float pv = __builtin_amdgcn_exp2f(sa[kb][e] - mnew); sa[kb][e] = pv; ps += pv; }
    lrun = lrun * alpha + ps;
#pragma unroll
    for (int bl = 0; bl < 2; ++bl)
#pragma unroll
      for (int e = 0; e < 16; ++e) oacc[bl][e] *= alpha;
#pragma unroll
    for (int kb = 0; kb < 2; ++kb)
#pragma unroll
      for (int s = 0; s < 2; ++s) {
        bf16x8 pf = pack8(sa[kb][8 * s + 0], sa[kb][8 * s + 1], sa[kb][8 * s + 2], sa[kb][8 * s + 3], sa[kb][8 * s + 4], sa[kb][8 * s + 5], sa[kb][8 * s + 6], sa[kb][8 * s + 7]);
#pragma unroll
        for (int bl = 0; bl < 2; ++bl) {
          bf16x8 av = *(const bf16x8*)(vsb + (bl * 32 + l31) * 144 + (kb * 32 + s * 16 + hh * 8) * 2);
          oacc[bl] = mfma32(av, pf, oacc[bl]);
        }
      }
  };
  gload(0, rk0, rv0); sstore(0, rk0, rv0);
  gload(1, rk0, rv0);
  __syncthreads();
#pragma unroll 1
  for (int kt = 0; kt < nkt; kt += 2) {
    if (kt + 2 < nkt) gload(kt + 2, rk1, rv1);
    tile(0);
    sstore(1, rk0, rv0);
    __syncthreads();
    if (kt + 3 < nkt) gload(kt + 3, rk0, rv0);
    tile(1);
    if (kt + 2 < nkt) sstore(0, rk1, rv1);
    __syncthreads();
  }
  lrun += __shfl_xor(lrun, 32);
  const float linv = 1.f / lrun;
  chk(p, 70, linv + oacc[0][0] + oacc[1][5]);
  bf16_t* orow = p.xn + (size_t)(rowq0 + wid * 32 + l31) * 1024 + 256 + h * 64;
#pragma unroll
  for (int bl = 0; bl < 2; ++bl)
#pragma unroll
    for (int e4 = 0; e4 < 4; ++e4) {
      const int dv = bl * 32 + 8 * e4 + 4 * hh;
      *(uint2*)(orow + dv) = DIS_ATT ? make_uint2(0u, 0u) : make_uint2(pk2(oacc[bl][e4 * 4 + 0] * linv, oacc[bl][e4 * 4 + 1] * linv), pk2(oacc[bl][e4 * 4 + 2] * linv, oacc[bl][e4 * 4 + 3] * linv));
    }
  __syncthreads();
}

__device__ void dnprep_task(const P& p, int l, int task, char* lds) {
  const int tid = otid(), lane = tid & 63, wid = __builtin_amdgcn_readfirstlane(tid >> 6);
  const int d = task & 1, h = (task >> 1) & 3, sc = (task >> 3) % 68, b = task / (8 * 68);
  const int L = sc < 64 ? 4096 : 256, t0 = sc < 64 ? sc * 64 : (sc - 64) * 64, rowbase = sc < 64 ? b * 4096 : NLAT + b * 256;
  bf16_t* qsb = (bf16_t*)lds; float* ks = (float*)(lds + 8448); float* vs = ks + 64 * 65; float* Am = vs + 64 * 65;
  float* gc = Am + 4096; float* be = gc + 64; float* eg = be + 64;
  bf16_t* ob = p.dnop + ((size_t)(((b * 4 + h) * 2 + d) * 68 + sc) * 5) * 4096;
  bf16_t *NWK = ob, *WVT = ob + 4096, *QD = ob + 8192, *AT = ob + 12288, *KDT = ob + 16384;
  if (wid == 0) {
    const int ip = lane, i = d ? 63 - ip : ip;
    const float* ba = p.Z + (size_t)(rowbase + t0 + i) * ZS + 1696;
    const float bl = ba[d * 4 + h], dl = ba[8 + d * 4 + h];
    const float beta = sigmoidf_(bl);
    const float xx = dl + p.dt_bias[(l * 2 + d) * 4 + h];
    const float sp = fmaxf(xx, 0.f) + log1pf(expf(-fabsf(xx)));
    float g = -expf(p.a_log[(l * 2 + d) * 4 + h]) * sp;
#pragma unroll
    for (int o = 1; o < 64; o <<= 1) { float t = __shfl_up(g, o); if (lane >= o) g += t; }
    gc[ip] = g; be[ip] = beta; eg[ip] = expf(g);
    if (ip == 63) p.gl[(((b * 4 + h) * 2 + d) * 68 + sc) * 32] = expf(g);
  }
  {
    const int ch = lane, tg = wid;
    const int tb = d ? t0 + 63 - (tg * 16 + 15) : t0 + tg * 16;
#pragma unroll 1
    for (int arr = 0; arr < 3; ++arr) {
      const int chan = arr * 256 + h * 64 + ch;
      float w[5];
#pragma unroll
      for (int j = 0; j < 5; ++j) w[j] = p.conv_w[(size_t)(l * 5 + j) * 768 + chan];
      float x[20];
#pragma unroll
      for (int k = 0; k < 20; ++k) { const int tt = tb - 2 + k; x[k] = (tt >= 0 && tt < L) ? p.Z[(size_t)(rowbase + tt) * ZS + 672 + chan] : 0.f; }
#pragma unroll
      for (int m = 0; m < 16; ++m) {
        float y = w[0] * x[m] + w[1] * x[m + 1] + w[2] * x[m + 2] + w[3] * x[m + 3] + w[4] * x[m + 4];
        y = siluf_(y);
        if (arr < 2) { float ss = wave_sum(y * y); y *= rsqrtf(ss + EPS); }
        const int i = tb + m - t0, ip = d ? 63 - i : i;
        if (arr == 0) qsb[ip * 66 + ch] = f2bf(y); else (arr == 1 ? ks : vs)[ip * 65 + ch] = y;
      }
    }
  }
  __syncthreads();
  {
    const int ti = tid >> 4, tj = tid & 15;
    float qk[4][4];
#pragma unroll
    for (int a = 0; a < 4; ++a)
#pragma unroll
      for (int bb = 0; bb < 4; ++bb) qk[a][bb] = 0.f;
#pragma unroll 4
    for (int c = 0; c < 64; ++c) {
      float qi[4], kj[4];
#pragma unroll
      for (int a = 0; a < 4; ++a) { qi[a] = bf2f(qsb[(4 * ti + a) * 66 + c]); kj[a] = ks[(4 * tj + a) * 65 + c]; }
#pragma unroll
      for (int a = 0; a < 4; ++a)
#pragma unroll
        for (int bb = 0; bb < 4; ++bb) qk[a][bb] += qi[a] * kj[bb];
    }
#pragma unroll
    for (int a = 0; a < 4; ++a) {
      const int ip = 4 * ti + a, tok_i = d ? 63 - ip : ip;
      float at[4];
#pragma unroll
      for (int bb = 0; bb < 4; ++bb) {
        const int jp = 4 * tj + bb;
        const float dec = (ip >= jp) ? expf(gc[ip] - gc[jp]) : 0.f;
        at[bb] = qk[a][bb] * 0.125f * dec;
      }
      const int tokj0 = d ? 60 - 4 * tj : 4 * tj;
      const int p0 = kpinv(tokj0);
      uint2 pkv = d ? make_uint2(pk2(at[3], at[2]), pk2(at[1], at[0])) : make_uint2(pk2(at[0], at[1]), pk2(at[2], at[3]));
      *(uint2*)(AT + tok_i * 64 + p0) = pkv;
    }
  }
  {
    float krow[64];
#pragma unroll
    for (int c = 0; c < 64; ++c) krow[c] = ks[lane * 65 + c];
    const float bi = be[lane], gi_ = gc[lane];
#pragma unroll 1
    for (int jj = 0; jj < 16; ++jj) {
      const int j = wid * 16 + jj;
      const float* kjp = ks + j * 65;
      float dot = 0.f;
#pragma unroll
      for (int c = 0; c < 64; ++c) dot = fmaf(krow[c], kjp[c], dot);
      Am[j * 64 + lane] = (lane > j) ? dot * bi * expf(gi_ - gc[j]) : 0.f;
    }
  }
  __syncthreads();
  {
    const float glast = gc[63];
#pragma unroll 1
    for (int it = 0; it < 2; ++it) {
      const int ct = tid + it * 256;
      const int r = ct >> 3, pb = (ct & 7) * 8;
      {
        const int ip = d ? 63 - r : r;
        const float s = 0.125f * eg[ip];
        float e[8];
#pragma unroll
        for (int k = 0; k < 8; ++k) { e[k] = bf2f(qsb[ip * 66 + kperm(pb + k)]) * s; chk(p, 61, e[k]); }
        *(bf16x8*)(QD + r * 64 + pb) = pack8(e[0], e[1], e[2], e[3], e[4], e[5], e[6], e[7]);
      }
      {
        float e[8];
#pragma unroll
        for (int k = 0; k < 8; ++k) { const int tok = kperm(pb + k), jp = d ? 63 - tok : tok; e[k] = ks[jp * 65 + r] * expf(glast - gc[jp]); chk(p, 62, e[k]); }
        *(bf16x8*)(KDT + r * 64 + pb) = pack8(e[0], e[1], e[2], e[3], e[4], e[5], e[6], e[7]);
      }
    }
  }
  __syncthreads();
  {
    const float* Wm = (wid < 2) ? vs : ks;
    float Arow[64];
#pragma unroll
    for (int j = 0; j < 64; ++j) Arow[j] = Am[j * 64 + lane];
    const float rs = be[lane] * ((wid >= 2) ? eg[lane] : 1.f);
    const int c0 = (wid & 1) * 32;
    const int tok = d ? 63 - lane : lane;
#pragma unroll 1
    for (int c = c0; c < c0 + 32; c += 4) {
      float a0 = Wm[lane * 65 + c] * rs, a1 = Wm[lane * 65 + c + 1] * rs, a2 = Wm[lane * 65 + c + 2] * rs, a3 = Wm[lane * 65 + c + 3] * rs;
#pragma unroll
      for (int j = 0; j < 63; ++j) {
        const float w0 = __uint_as_float(__builtin_amdgcn_readlane(__float_as_uint(a0), j));
        const float w1 = __uint_as_float(__builtin_amdgcn_readlane(__float_as_uint(a1), j));
        const float w2 = __uint_as_float(__builtin_amdgcn_readlane(__float_as_uint(a2), j));
        const float w3 = __uint_as_float(__builtin_amdgcn_readlane(__float_as_uint(a3), j));
        a0 = fmaf(-Arow[j], w0, a0); a1 = fmaf(-Arow[j], w1, a1); a2 = fmaf(-Arow[j], w2, a2); a3 = fmaf(-Arow[j], w3, a3);
      }
      if (wid < 2) {
        WVT[c * 64 + tok] = f2bf(a0); WVT[(c + 1) * 64 + tok] = f2bf(a1); WVT[(c + 2) * 64 + tok] = f2bf(a2); WVT[(c + 3) * 64 + tok] = f2bf(a3);
      } else {
        NWK[tok * 64 + kpinv(c)] = f2bf(-a0); NWK[tok * 64 + kpinv(c + 1)] = f2bf(-a1); NWK[tok * 64 + kpinv(c + 2)] = f2bf(-a2); NWK[tok * 64 + kpinv(c + 3)] = f2bf(-a3);
      }
    }
  }
  __syncthreads();
}

__device__ void dnrec_task(const P& p, int l, int task, char* lds) {
  const int tid = otid(), lane = tid & 63, wid = __builtin_amdgcn_readfirstlane(tid >> 6);
  const int d = task & 1, h = (task >> 1) & 3, b = task >> 3;
  const int c = lane & 15, q = lane >> 4;
  const int dv = wid * 16 + c;
  const char* LN = lds; const char* LW = lds + 9216; const char* LQ = lds + 18432; const char* LA = lds + 27648; const char* LK = lds + 36864;
  bf16_t* osd = (bf16_t*)p.os + (size_t)d * NROWS * 256;
  f32x4 S[4];
#pragma unroll
  for (int mt = 0; mt < 4; ++mt) S[mt] = (f32x4){0.f, 0.f, 0.f, 0.f};
  u32x4 pre[10];
  auto opblk = [&](int n) -> const char* {
    const int sc = d ? 67 - n : (n < 4 ? 64 + n : n - 4);
    return (const char*)(p.dnop + ((size_t)(((b * 4 + h) * 2 + d) * 68 + sc) * 5) * 4096);
  };
  auto prefetch = [&](int n) {
    const char* ob = opblk(n);
#pragma unroll
    for (int i = 0; i < 10; ++i) pre[i] = *(const u32x4*)(ob + (size_t)(tid + i * 256) * 16);
  };
  auto stage = [&]() {
#pragma unroll
    for (int i = 0; i < 10; ++i) { const int idx = tid + i * 256, m = idx >> 9, r = (idx >> 3) & 63, ch = idx & 7; *(u32x4*)(lds + m * 9216 + r * 144 + ch * 16) = pre[i]; }
  };
  prefetch(0);
#pragma unroll 1
  for (int n = 0; n < 68; ++n) {
    const int sc = d ? 67 - n : (n < 4 ? 64 + n : n - 4);
    const int rowb = sc < 64 ? b * 4096 + sc * 64 : NLAT + b * 256 + (sc - 64) * 64;
    const float egl = p.gl[(((b * 4 + h) * 2 + d) * 68 + sc) * 32];
    __syncthreads();
    stage();
    __syncthreads();
    if (n + 1 < 68) prefetch(n + 1);
    bf16x8 sb[2];
#pragma unroll
    for (int ks = 0; ks < 2; ++ks)
      sb[ks] = pack8(S[2 * ks][0], S[2 * ks][1], S[2 * ks][2], S[2 * ks][3], S[2 * ks + 1][0], S[2 * ks + 1][1], S[2 * ks + 1][2], S[2 * ks + 1][3]);
    f32x4 va[4];
#pragma unroll
    for (int mt = 0; mt < 4; ++mt) {
      uint2 wv = *(const uint2*)(LW + dv * 144 + (mt * 16 + q * 4) * 2);
      va[mt] = (f32x4){__uint_as_float(wv.x << 16), __uint_as_float(wv.x & 0xffff0000u), __uint_as_float(wv.y << 16), __uint_as_float(wv.y & 0xffff0000u)};
#pragma unroll
      for (int ks = 0; ks < 2; ++ks) {
        bf16x8 a = *(const bf16x8*)(LN + (mt * 16 + c) * 144 + (ks * 32 + q * 8) * 2);
        va[mt] = mfma16(a, sb[ks], va[mt]);
      }
    }
    bf16x8 vb[2];
#pragma unroll
    for (int ks = 0; ks < 2; ++ks)
      vb[ks] = pack8(va[2 * ks][0], va[2 * ks][1], va[2 * ks][2], va[2 * ks][3], va[2 * ks + 1][0], va[2 * ks + 1][1], va[2 * ks + 1][2], va[2 * ks + 1][3]);
#pragma unroll
    for (int mt = 0; mt < 4; ++mt) {
      f32x4 oa = {0.f, 0.f, 0.f, 0.f};
#pragma unroll
      for (int ks = 0; ks < 2; ++ks) {
        bf16x8 a = *(const bf16x8*)(LQ + (mt * 16 + c) * 144 + (ks * 32 + q * 8) * 2);
        oa = mfma16(a, sb[ks], oa);
        bf16x8 a2 = *(const bf16x8*)(LA + (mt * 16 + c) * 144 + (ks * 32 + q * 8) * 2);
        oa = mfma16(a2, vb[ks], oa);
      }
      bf16_t* od = osd + (size_t)(rowb + mt * 16 + q * 4) * 256 + h * 64 + dv;
#pragma unroll
      for (int j = 0; j < 4; ++j) od[(size_t)j * 256] = f2bf(oa[j]);
    }
#pragma unroll
    for (int mt = 0; mt < 4; ++mt) {
      f32x4 sn = S[mt] * egl;
#pragma unroll
      for (int ks = 0; ks < 2; ++ks) {
        bf16x8 a = *(const bf16x8*)(LK + (mt * 16 + c) * 144 + (ks * 32 + q * 8) * 2);
        sn = mfma16(a, vb[ks], sn);
      }
      S[mt] = sn;
    }
  }
  __syncthreads();
}

__device__ void dnfin_task(const P& p, int l, int task) {
  const int tid = otid();
  const int row = task * 64 + (tid >> 2), h = tid & 3;
  const bf16_t* o0 = (const bf16_t*)p.os + (size_t)row * 256 + h * 64;
  const bf16_t* o1 = o0 + (size_t)NROWS * 256;
  const float* gt = p.Z + (size_t)row * ZS + 1440 + h * 64;
  const float* nw = p.dn_norm_w + l * 64;
  bf16_t* dst = p.xn + (size_t)row * 1024 + 768 + h * 64;
  float ss = 0.f;
#pragma unroll
  for (int k = 0; k < 8; ++k) {
    const u32x4 a = *(const u32x4*)(o0 + k * 8), bq = *(const u32x4*)(o1 + k * 8);
#pragma unroll
    for (int e = 0; e < 4; ++e) {
      const float v0 = __uint_as_float(a[e] << 16) + __uint_as_float(bq[e] << 16);
      const float v1 = __uint_as_float(a[e] & 0xffff0000u) + __uint_as_float(bq[e] & 0xffff0000u);
      ss += v0 * v0 + v1 * v1;
    }
  }
  const float rinv = rsqrtf(ss * (1.f / 64.f) + EPS);
#pragma unroll
  for (int k = 0; k < 8; ++k) {
    const u32x4 a = *(const u32x4*)(o0 + k * 8), bq = *(const u32x4*)(o1 + k * 8);
    const f32x4 g0 = *(const f32x4*)(gt + k * 8), g1 = *(const f32x4*)(gt + k * 8 + 4);
    const f32x4 w0 = *(const f32x4*)(nw + k * 8), w1 = *(const f32x4*)(nw + k * 8 + 4);
    float o[8];
#pragma unroll
    for (int e = 0; e < 4; ++e) {
      o[2 * e] = __uint_as_float(a[e] << 16) + __uint_as_float(bq[e] << 16);
      o[2 * e + 1] = __uint_as_float(a[e] & 0xffff0000u) + __uint_as_float(bq[e] & 0xffff0000u);
    }
    u32x4 r;
    r[0] = pk2(o[0] * rinv * w0[0] * siluf_(g0[0]), o[1] * rinv * w0[1] * siluf_(g0[1]));
    r[1] = pk2(o[2] * rinv * w0[2] * siluf_(g0[2]), o[3] * rinv * w0[3] * siluf_(g0[3]));
    r[2] = pk2(o[4] * rinv * w1[0] * siluf_(g1[0]), o[5] * rinv * w1[1] * siluf_(g1[1]));
    r[3] = pk2(o[6] * rinv * w1[2] * siluf_(g1[2]), o[7] * rinv * w1[3] * siluf_(g1[3]));
    *(u32x4*)(dst + k * 8) = r;
  }
}

struct Bar { unsigned epoch, nx, nxcd; int xcc; unsigned* garr; unsigned* arr; };
DEV int xcc_id() { return (int)(__builtin_amdgcn_s_getreg(6164) & 15u); }
DEV void gbar(Bar& b) {
  asm volatile("s_waitcnt vmcnt(0) lgkmcnt(0)" ::: "memory");
  __syncthreads();
  b.epoch += 1;
  if (threadIdx.x == 0) {
    const unsigned old = __hip_atomic_fetch_add(b.arr, 1u, __ATOMIC_RELAXED, __HIP_MEMORY_SCOPE_AGENT);
    if (old + 1 == b.epoch * b.nx) {
      __builtin_amdgcn_fence(__ATOMIC_RELEASE, "agent");
      asm volatile("s_waitcnt vmcnt(0)" ::: "memory");
      __hip_atomic_fetch_add(b.garr, 1u, __ATOMIC_RELAXED, __HIP_MEMORY_SCOPE_AGENT);
    }
    const unsigned target = b.epoch * b.nxcd;
    while (__hip_atomic_load(b.garr, __ATOMIC_RELAXED, __HIP_MEMORY_SCOPE_AGENT) < target) __builtin_amdgcn_s_sleep(2);
    __builtin_amdgcn_fence(__ATOMIC_ACQUIRE, "agent");
    asm volatile("s_waitcnt vmcnt(0)" ::: "memory");
  }
  __syncthreads();
}
DEV void gsync(cg::grid_group& grid) {
  asm volatile("s_waitcnt vmcnt(0) lgkmcnt(0)" ::: "memory");
  grid.sync();
  if (threadIdx.x < 64) {
    __builtin_amdgcn_fence(__ATOMIC_ACQUIRE, "agent");
    asm volatile("s_waitcnt vmcnt(0)" ::: "memory");
  }
  __syncthreads();
}

__device__ void run_phase(const P& p, int ph, char* lds) {
  const int tid = threadIdx.x;
  if (ph == 0) {
    phase0(p, lds);
    return;
  }
  const int l = (ph - 1) / 11, q = (ph - 1) % 11;
  const int Mt = (l < 3) ? 136 : 128;
  switch (q) {
    case 0: {
      const int nnorm = 1088;
      for (int t = blockIdx.x; t < nnorm + 2864; t += gridDim.x) {
        if (t < nnorm) { norm_task(p, l, 0, t); continue; }
        int u = t - nnorm;
        float* tile = (float*)lds;
        if (u < 448) { conv_tile(p.w_in + (size_t)l * 1024 * 1712, 1024, 1712, p.wt_in, u / 28, u % 28, tile); continue; } u -= 448;
        if (u < 256) { conv_tile(p.w_out + (size_t)l * 1024 * 1024, 1024, 1024, p.wt_out, u / 16, u % 16, tile); continue; } u -= 256;
        if (u < 1024) { conv_tile(p.w_ff1 + (size_t)l * 1024 * 4096, 1024, 4096, p.wt_ff1, u / 64, u % 64, tile); continue; } u -= 1024;
        if (u < 1024) { conv_tile(p.w_ff2 + (size_t)l * 4096 * 1024, 4096, 1024, p.wt_ff2, u / 16, u % 16, tile); continue; } u -= 1024;
        if (u < 48) { conv_tile(p.w_uq + (size_t)l * 256 * 768, 256, 768, p.wt_uq, u / 12, u % 12, tile); continue; } u -= 48;
        if (u < 32) { conv_tile(p.w_ukv + (size_t)l * 128 * 1024, 128, 1024, p.wt_ukv, u / 16, u % 16, tile); continue; } u -= 32;
        conv_tile(p.glu_w + (size_t)l * 256 * 512, 256, 512, p.wt_glu, u / 8, u % 8, tile);
      }
    } break;
    case 1: gemm_phase<0>(p, l, p.xn, 1024, p.wt_in, 1024, 136, 14, 1024, 0, lds); break;
    case 2:
      for (int t = blockIdx.x; t < 272 + 2176; t += gridDim.x) {
        if (t < 2176) dnprep_task(p, l, t, lds);
        else kv_task(p, l, t - 2176, lds);
      }
      break;
    case 3:
      for (int t = blockIdx.x; t < 32 + 2176; t += gridDim.x) {
        if (t < 32) dnrec_task(p, l, t, lds);
        else s5p1_task(p, l, t - 32);
      }
      break;
    case 4: {
      const int nt = 1024 + 272 + 272 + (l == 3 ? 0 : 64);
      int* slot = (int*)(lds + LDS_BYTES - 16);
      unsigned* qc = p.ctr + 8 + l;
      int qbase = 0;
      if (gridDim.x == 512) {
        const int x = blockIdx.x & 7, j = blockIdx.x >> 3;
        for (int r = 0; r < 2; ++r) attn_task(p, l, (x * 4 + r * 2 + (j >> 5)) * 32 + (j & 31), lds);
        qbase = 1024;
      }
      while (true) {
        __syncthreads();
        if (threadIdx.x == 0) *slot = qbase + (int)atomicAdd(qc, 1u);
        __syncthreads();
        const int t = *slot;
        __syncthreads();
        if (t >= nt) break;
        if (t < 1024) attn_task(p, l, t, lds);
        else if (t < 1296) s5p3_task(p, l, t - 1024, lds);
        else if (t < 1568) dnfin_task(p, l, t - 1296);
        else attn_task(p, l, t - 544, lds);
      }
    } break;
    case 5: break;
    case 6: gemm_phase<1>(p, l, p.xn, 1024, p.wt_out, 1024, Mt, 8, 1024, 2, lds); break;
    case 7: for (int t = blockIdx.x; t < Mt * 8; t += gridDim.x) norm_task(p, l, 1, t); break;
    case 8: gemm_phase<2>(p, l, p.xn, 1024, p.wt_ff1, 1024, Mt, 32, 1024, 0, lds); break;
    case 9: gemm_phase<1>(p, l, p.H, 4096, p.wt_ff2, 4096, Mt, 8, 4096, 5, lds); break;
    default: break;
  }
}


#define NPH 45
__global__ void __launch_bounds__(256, 2) fwd_megakernel(P p, int pb, int pe) {
  extern __shared__ __attribute__((aligned(16))) char lds[];
  cg::grid_group grid = cg::this_grid();
  Bar bar;
  bar.epoch = 0; bar.xcc = xcc_id(); bar.garr = p.ctr + 64; bar.arr = p.ctr + 1024 + bar.xcc * 32; bar.nx = 0; bar.nxcd = 0;
  if (threadIdx.x == 0) __hip_atomic_fetch_add(p.ctr + 256 + bar.xcc * 32, 1u, __ATOMIC_RELAXED, __HIP_MEMORY_SCOPE_AGENT);
#pragma unroll 1
  for (int ph = pb; ph < pe; ++ph) {
    const int q = (ph - 1) % 11;
    const int nrep = ((ph >= 1 && REPQ >= 0 && q == REPQ) || (ph == 0 && REPQ == 100)) ? 2 : 1;
#pragma unroll 1
    for (int rep = 0; rep < nrep; ++rep) {
      run_phase(p, ph, lds);
      if ((ph + 1 < pe || rep + 1 < nrep) && !(ph >= 1 && (q == 5 || q == 10))) {
        if (ph == 0 && rep == 0) {
          gsync(grid);
          unsigned nxcd = 0;
          for (int x = 0; x < 16; ++x) nxcd += (__hip_atomic_load(p.ctr + 256 + x * 32, __ATOMIC_RELAXED, __HIP_MEMORY_SCOPE_AGENT) != 0u) ? 1u : 0u;
          bar.nxcd = nxcd;
          bar.nx = __hip_atomic_load(p.ctr + 256 + bar.xcc * 32, __ATOMIC_RELAXED, __HIP_MEMORY_SCOPE_AGENT);
        } else gbar(bar);
      }
    }
  }
}

extern "C" void kernel_launch(void* const* d_in, const int* in_sizes, int n_in, void* d_out, int out_size, void* d_ws, size_t ws_size, hipStream_t stream) {
  P p{};
  const float** fp = (const float**)&p;
  for (int i = 0; i < 31; ++i) fp[i] = (const float*)d_in[i];
  p.out = (float*)d_out;
  char* w = (char*)d_ws;
  size_t off = 0;
  auto take = [&](size_t bytes) { char* r = w + off; off += (bytes + 255) & ~(size_t)255; return r; };
  p.ctr = (unsigned*)take(8192);
  p.wt_in = (bf16_t*)take((size_t)1792 * 1024 * 2);
  p.wt_out = (bf16_t*)take((size_t)1024 * 1024 * 2);
  p.wt_ff1 = (bf16_t*)take((size_t)4096 * 1024 * 2);
  p.wt_ff2 = (bf16_t*)take((size_t)1024 * 4096 * 2);
  p.wt_uq = (bf16_t*)take((size_t)768 * 256 * 2);
  p.wt_ukv = (bf16_t*)take((size_t)1024 * 128 * 2);
  p.wt_glu = (bf16_t*)take((size_t)512 * 256 * 2);
  p.mods = (float*)take((size_t)4 * 5 * 6144 * 4);
  p.rope = (float*)take(4096);
  p.xc = (float*)take((size_t)1024 * 1024 * 4);
  p.xn = (bf16_t*)take((size_t)NROWS * 1024 * 2);
  p.E = (float*)take((size_t)128 * 68 * 64 * 2 * 4);
  p.os = (float*)take((size_t)NROWS * 256 * 4);
  p.gl = (float*)take((size_t)4 * 4 * 2 * 68 * 4 * 32);
  p.ys = (bf16_t*)take((size_t)NROWS * 256 * 2);
  p.dnop = (bf16_t*)take((size_t)4 * 4 * 2 * 68 * 5 * 4096 * 2);
  char* r1 = take((size_t)NROWS * ZS * 4 + (size_t)32 * 4352 * 96 * 2 + (size_t)32 * 64 * 4352 * 2);
  p.Z = (float*)r1;
  p.Kb = (bf16_t*)(r1 + (size_t)NROWS * ZS * 4);
  p.Vt = (bf16_t*)(r1 + (size_t)NROWS * ZS * 4 + (size_t)32 * 4352 * 96 * 2);
  p.H = (bf16_t*)r1;
  p.fill_begin = (u32x4*)((char*)p.xc); p.fill_n = (size_t)((w + off) - (char*)p.xc) / 16;
  if (off > ws_size) { fprintf(stderr, "workspace too small: need %zu have %zu\n", off, ws_size); return; }
  hipMemsetAsync(p.ctr, 0, 8192, stream);
  hipFuncSetAttribute((const void*)fwd_megakernel, hipFuncAttributeMaxDynamicSharedMemorySize, LDS_BYTES);
  int dev = 0, cus = 0, per_cu = 0;
  hipGetDevice(&dev);
  hipDeviceGetAttribute(&cus, hipDeviceAttributeMultiprocessorCount, dev);
  hipOccupancyMaxActiveBlocksPerMultiprocessor(&per_cu, fwd_megakernel, 256, LDS_BYTES);
  if (per_cu > 2) per_cu = 2;
  int grid_blocks = cus * per_cu;
#ifdef MULTI_LAUNCH
  hipError_t e = hipSuccess;
  for (int ph = 0; ph < NPH; ++ph) fwd_megakernel<<<dim3(grid_blocks), dim3(256), LDS_BYTES, stream>>>(p, ph, ph + 1);
#else
  int pb = 0, pe = NPH;
  void* args[] = {&p, &pb, &pe};
  hipError_t e = hipLaunchCooperativeKernel((void*)fwd_megakernel, dim3(grid_blocks), dim3(256), args, LDS_BYTES, stream);
#endif
  if (e != hipSuccess) fprintf(stderr, "cooperative launch failed: %s (grid %d)\n", hipGetErrorString(e), grid_blocks);
}
```

```cpp
#include <hip/hip_runtime.h>
#include <hip/hip_cooperative_groups.h>
#include <cstdio>
#include <cstdint>
namespace cg = cooperative_groups;

typedef unsigned short bf16_t;
typedef short bf16x8 __attribute__((ext_vector_type(8)));
typedef float f32x4 __attribute__((ext_vector_type(4)));
typedef float f32x16 __attribute__((ext_vector_type(16)));
typedef unsigned u32x4 __attribute__((ext_vector_type(4)));

#define DEV __device__ __forceinline__
#define NLAT 16384
#define NROWS 17408
#define ZW 1712
#define ZS 1792
#define LDS_BYTES 65536
#define EPS 1e-6f
#define REPQ (-1)
#define DIS_DN 0
#define DIS_ATT 0
#define DIS_S5 0

struct P {
  const float *x, *c, *ctx, *c_ctx, *w_ada, *b_ada, *norm1_w, *w_in, *lam_re, *lam_im, *log_dt, *b_re, *b_im, *c_re, *c_im,
      *s5_d, *glu_w, *qn_w, *kvn_w, *w_uq, *w_ukv, *q_gain, *k_gain, *conv_w, *a_log, *dt_bias, *dn_norm_w, *w_out, *norm2_w, *w_ff1, *w_ff2;
  float* out;
  bf16_t *wt_in, *wt_out, *wt_ff1, *wt_ff2, *wt_uq, *wt_ukv, *wt_glu;
  float *mods, *rope, *xc, *Z, *E, *os, *gl;
  bf16_t *xn, *Kb, *Vt, *H, *dnop, *ys;
  unsigned* ctr;
  u32x4* fill_begin; size_t fill_n;
};

DEV int otid() { int t = threadIdx.x; asm volatile("" : "+v"(t)); return t; }
DEV float wave_sum(float v) {
#pragma unroll
  for (int o = 32; o; o >>= 1) v += __shfl_xor(v, o);
  return v;
}
typedef float f32x2 __attribute__((ext_vector_type(2)));
typedef __bf16 bf16x2_t __attribute__((ext_vector_type(2)));
DEV unsigned pk2(float lo, float hi) { f32x2 v = {lo, hi}; bf16x2_t b = __builtin_convertvector(v, bf16x2_t); return __builtin_bit_cast(unsigned, b); }
DEV bf16_t f2bf(float f) { return (bf16_t)(pk2(f, 0.f) & 0xffffu); }
DEV float bf2f(bf16_t b) { return __uint_as_float(((unsigned)b) << 16); }
DEV float sigmoidf_(float x) { return 1.f / (1.f + __expf(-x)); }
DEV float siluf_(float x) { return x / (1.f + __expf(-x)); }
DEV float geluf_(float x) { float u = 0.7978845608028654f * (x + 0.044715f * x * x * x); return x / (1.f + __expf(-2.f * u)); }
DEV f32x16 mfma32(bf16x8 a, bf16x8 b, f32x16 c) { return __builtin_amdgcn_mfma_f32_32x32x16_bf16(a, b, c, 0, 0, 0); }
DEV f32x4 mfma16(bf16x8 a, bf16x8 b, f32x4 c) { return __builtin_amdgcn_mfma_f32_16x16x32_bf16(a, b, c, 0, 0, 0); }
DEV bf16x8 pack8(float a0, float a1, float a2, float a3, float a4, float a5, float a6, float a7) {
  union { unsigned u[4]; bf16x8 v; } t;
  t.u[0] = pk2(a0, a1); t.u[1] = pk2(a2, a3); t.u[2] = pk2(a4, a5); t.u[3] = pk2(a6, a7);
  return t.v;
}
DEV int swap23(int d) { return (d & ~12) | ((d & 4) << 1) | ((d & 8) >> 1); }
DEV int kperm(int p) { return (p & 0x23) | ((p & 0x18) >> 1) | ((p & 0x04) << 2); }
DEV int kpinv(int x) { return (x & 0x23) | ((x & 0x0C) << 1) | ((x & 0x10) >> 2); }

DEV void chk(const P& p, int stage, float v) {
#ifdef DBGCHK
  if (!(fabsf(v) < 1e30f)) atomicMax(p.ctr + 8, (unsigned)(1000 - stage));
#endif
}
DEV const float* xrow_src(const P& p, bool from_input, int r) {
  if (r < NLAT) return (from_input ? p.x : p.out) + (size_t)r * 1024;
  return (from_input ? p.ctx : p.xc) + (size_t)(r - NLAT) * 1024;
}
DEV float* xrow_dst(const P& p, int r) { return r < NLAT ? p.out + (size_t)r * 1024 : p.xc + (size_t)(r - NLAT) * 1024; }

__device__ void phase0(const P& p, char* lds) {
  float* sc = (float*)lds;
  float* red = sc + 5120;
  const int tid = otid();
  bool loaded = false;
  for (int t = blockIdx.x; t < 385; t += gridDim.x) {
    if (t == 384) {
      for (int i = tid; i < 512; i += 256) {
        int pos = i >> 3, f = i & 7;
        float inv = powf(10000.f, -(float)f / 8.f);
        float ang = (float)pos * inv;
        p.rope[i * 2] = cosf(ang); p.rope[i * 2 + 1] = sinf(ang);
      }
      continue;
    }
    if (!loaded) {
      for (int i = tid; i < 5120; i += 256) { int m = i >> 10, k = i & 1023; float v = m < 4 ? p.c[m * 1024 + k] : p.c_ctx[k]; sc[i] = v / (1.f + expf(-v)); }
      __syncthreads(); loaded = true;
    }
    const int l = t / 96, j0 = (t % 96) * 64, col = tid & 63, kq = tid >> 6;
    const float* w = p.w_ada + (size_t)l * 1024 * 6144 + j0 + col;
    float a0 = 0, a1 = 0, a2 = 0, a3 = 0, a4 = 0;
    for (int k = kq * 256; k < kq * 256 + 256; ++k) {
      float wv = w[(size_t)k * 6144];
      a0 += sc[k] * wv; a1 += sc[1024 + k] * wv; a2 += sc[2048 + k] * wv; a3 += sc[3072 + k] * wv; a4 += sc[4096 + k] * wv;
    }
    red[(kq * 5 + 0) * 64 + col] = a0; red[(kq * 5 + 1) * 64 + col] = a1; red[(kq * 5 + 2) * 64 + col] = a2;
    red[(kq * 5 + 3) * 64 + col] = a3; red[(kq * 5 + 4) * 64 + col] = a4;
    __syncthreads();
    for (int i = tid; i < 320; i += 256) {
      int m = i >> 6, cc = i & 63;
      float s = red[(0 * 5 + m) * 64 + cc] + red[(1 * 5 + m) * 64 + cc] + red[(2 * 5 + m) * 64 + cc] + red[(3 * 5 + m) * 64 + cc];
      p.mods[(size_t)(l * 5 + m) * 6144 + j0 + cc] = s + p.b_ada[l * 6144 + j0 + cc];
    }
    __syncthreads();
  }
}

__device__ void conv_tile(const float* src, int K, int N, bf16_t* dst, int kt, int nt, float* tile) {
  const int tid = otid();
  const int k0 = kt * 64, n0 = nt * 64;
#pragma unroll
  for (int i = 0; i < 4; ++i) {
    int r = (tid >> 4) + i * 16, c4 = (tid & 15) * 4;
    float4 v = make_float4(0.f, 0.f, 0.f, 0.f);
    if (n0 + c4 < N) v = *(const float4*)(src + (size_t)(k0 + r) * N + n0 + c4);
    tile[r * 65 + c4 + 0] = v.x; tile[r * 65 + c4 + 1] = v.y; tile[r * 65 + c4 + 2] = v.z; tile[r * 65 + c4 + 3] = v.w;
  }
  __syncthreads();
  const int n = tid >> 2, kq = tid & 3;
  unsigned pk[8];
#pragma unroll
  for (int i = 0; i < 8; ++i) pk[i] = pk2(tile[(kq * 16 + 2 * i) * 65 + n], tile[(kq * 16 + 2 * i + 1) * 65 + n]);
  uint4* d = (uint4*)(dst + (size_t)(n0 + n) * K + k0 + kq * 16);
  d[0] = make_uint4(pk[0], pk[1], pk[2], pk[3]); d[1] = make_uint4(pk[4], pk[5], pk[6], pk[7]);
  __syncthreads();
}

__device__ void norm_task(const P& p, int l, int which, int task) {
  const int tid = otid(), wid = tid >> 6, lane = tid & 63;
  const float* nw = (which ? p.norm2_w : p.norm1_w) + l * 1024;
  const bool from_input = (l == 0 && which == 0);
#pragma unroll
  for (int rr = 0; rr < 4; ++rr) {
    const int r = task * 16 + wid * 4 + rr;
    const float* xr = xrow_src(p, from_input, r);
    const int m = r < NLAT ? (r >> 12) : 4;
    const float* sh = p.mods + (size_t)((l * 5 + m) * 6 + (which ? 3 : 0)) * 1024;
    const float* scl = sh + 1024;
    float4 v[4]; float ss = 0.f;
#pragma unroll
    for (int i = 0; i < 4; ++i) { v[i] = *(const float4*)(xr + i * 256 + lane * 4); ss += v[i].x * v[i].x + v[i].y * v[i].y + v[i].z * v[i].z + v[i].w * v[i].w; }
    ss = wave_sum(ss);
    const float rinv = rsqrtf(ss * (1.f / 1024.f) + EPS);
#pragma unroll
    for (int i = 0; i < 4; ++i) {
      const int c = i * 256 + lane * 4;
      float4 w4 = *(const float4*)(nw + c), s4 = *(const float4*)(scl + c), h4 = *(const float4*)(sh + c);
      float y0 = v[i].x * rinv * w4.x * (1.f + s4.x) + h4.x, y1 = v[i].y * rinv * w4.y * (1.f + s4.y) + h4.y;
      float y2 = v[i].z * rinv * w4.z * (1.f + s4.z) + h4.z, y3 = v[i].w * rinv * w4.w * (1.f + s4.w) + h4.w;
      chk(p, 10, s4.x + h4.x + w4.x); chk(p, which ? 110 : 20, y0 + y1 + y2 + y3);
      *(uint2*)(p.xn + (size_t)r * 1024 + c) = make_uint2(pk2(y0, y1), pk2(y2, y3));
    }
  }
}

template <int EPI>
__device__ void gemm_phase(const P& p, int l, const bf16_t* A, int lda, const bf16_t* Bt, int ldb, int Mt, int Nt, int K, int gi, char* lds) {
  const int tid = otid(), lane = tid & 63, wid = tid >> 6, wm = wid >> 1, wn = wid & 1;
  char* sA = lds; char* sB = lds + 128 * 144;
  const int srow = tid >> 3, sch = tid & 7;
  const bool xcdmap = (Nt == 8) && ((gridDim.x & 7) == 0);
  const int nper = xcdmap ? (Mt >> 3) * Nt : Mt * Nt;
  for (int v = xcdmap ? (blockIdx.x >> 3) : blockIdx.x; v < nper; v += xcdmap ? (gridDim.x >> 3) : gridDim.x) {
    const int mt = xcdmap ? (v / Nt) * 8 + (blockIdx.x & 7) : v / Nt, nt = v % Nt, m0 = mt * 128, n0 = nt * 128;
    f32x16 acc[2][2];
#pragma unroll
    for (int i = 0; i < 2; ++i)
#pragma unroll
      for (int j = 0; j < 2; ++j)
#pragma unroll
        for (int e = 0; e < 16; ++e) acc[i][j][e] = 0.f;
    const bf16_t* Ap = A + (size_t)(m0 + srow) * lda + sch * 8;
    const bf16_t* Bp = Bt + (size_t)(n0 + srow) * ldb + sch * 8;
    u32x4 ra[4], rb[4];
#pragma unroll
    for (int i = 0; i < 4; ++i) { ra[i] = *(const u32x4*)(Ap + (size_t)i * 32 * lda); rb[i] = *(const u32x4*)(Bp + (size_t)i * 32 * ldb); }
    const int nk = K >> 6;
#pragma unroll 1
    for (int kt = 0; kt < nk; ++kt) {
      __syncthreads();
#pragma unroll
      for (int i = 0; i < 4; ++i) {
        *(u32x4*)(sA + (srow + i * 32) * 144 + sch * 16) = ra[i];
        *(u32x4*)(sB + (srow + i * 32) * 144 + sch * 16) = rb[i];
      }
      __syncthreads();
      if (kt + 1 < nk) {
        const int k0 = (kt + 1) * 64;
#pragma unroll
        for (int i = 0; i < 4; ++i) { ra[i] = *(const u32x4*)(Ap + (size_t)i * 32 * lda + k0); rb[i] = *(const u32x4*)(Bp + (size_t)i * 32 * ldb + k0); }
      }
#pragma unroll
      for (int ks = 0; ks < 4; ++ks) {
        bf16x8 a[2], b[2];
#pragma unroll
        for (int i = 0; i < 2; ++i) a[i] = *(const bf16x8*)(sA + (wm * 64 + i * 32 + (lane & 31)) * 144 + (ks * 16 + (lane >> 5) * 8) * 2);
#pragma unroll
        for (int j = 0; j < 2; ++j) b[j] = *(const bf16x8*)(sB + (wn * 64 + j * 32 + (lane & 31)) * 144 + (ks * 16 + (lane >> 5) * 8) * 2);
#pragma unroll
        for (int i = 0; i < 2; ++i)
#pragma unroll
          for (int j = 0; j < 2; ++j) acc[i][j] = mfma32(a[i], b[j], acc[i][j]);
      }
    }
    __syncthreads();
    float* sC = (float*)lds;
#pragma unroll
    for (int i = 0; i < 2; ++i)
#pragma unroll
      for (int j = 0; j < 2; ++j)
#pragma unroll
        for (int e = 0; e < 16; ++e)
          sC[(wm * 64 + i * 32 + 8 * (e >> 2) + 4 * (lane >> 5) + (e & 3)) * 128 + wn * 64 + j * 32 + (lane & 31)] = acc[i][j][e];
    __syncthreads();
#pragma unroll 2
    for (int it = 0; it < 16; ++it) {
      const int idx = tid + it * 256, r = idx >> 5, c4 = (idx & 31) * 4;
      const f32x4 v = *(const f32x4*)(sC + r * 128 + c4);
      const int row = m0 + r, col = n0 + c4;
      chk(p, EPI == 0 ? 30 : (EPI == 2 ? 120 : (gi == 2 ? 100 : 130)), v[0] + v[1] + v[2] + v[3]);
      if (EPI == 0) { if (col < ZW) *(f32x4*)(p.Z + (size_t)row * ZS + col) = v; }
      else if (EPI == 1) {
        const int m = row < NLAT ? (row >> 12) : 4;
        const f32x4 g = *(const f32x4*)(p.mods + (size_t)((l * 5 + m) * 6 + gi) * 1024 + col);
        const f32x4 xo = *(const f32x4*)(xrow_src(p, (l == 0 && gi == 2), row) + col);
        f32x4 xr = xo + g * v;
#ifdef SANITIZE
#pragma unroll
        for (int q = 0; q < 4; ++q) if (!(fabsf(xr[q]) < 1e30f)) xr[q] = 0.f;
#endif
        *(f32x4*)(xrow_dst(p, row) + col) = xr;
      } else {
        const float r0 = fmaxf(v[0], 0.f), r1 = fmaxf(v[1], 0.f), r2 = fmaxf(v[2], 0.f), r3 = fmaxf(v[3], 0.f);
        *(uint2*)(p.H + (size_t)row * 4096 + col) = make_uint2(pk2(r0 * r0, r1 * r1), pk2(r2 * r2, r3 * r3));
      }
    }
  }
}

struct S5D { float ar, ai; float bbr[16], bbi[16]; };
DEV void s5_disc(const P& p, int l, int dir, int g, int lane, S5D& d) {
  const int idx = (l * 2 + dir) * 16 + g;
  const float lr = p.lam_re[idx * 64 + lane], li = p.lam_im[idx * 64 + lane];
  const float dt = expf(p.log_dt[idx]);
  const float mag = expf(lr * dt);
  float sn, cs; sincosf(li * dt, &sn, &cs);
  d.ar = mag * cs; d.ai = mag * sn;
  const float den = lr * lr + li * li;
  const float fr = ((d.ar - 1.f) * lr + d.ai * li) / den;
  const float fi = (d.ai * lr - (d.ar - 1.f) * li) / den;
  const float* br = p.b_re + (size_t)(idx * 64 + lane) * 16;
  const float* bi = p.b_im + (size_t)(idx * 64 + lane) * 16;
#pragma unroll
  for (int c = 0; c < 16; ++c) { float r = br[c], i = bi[c]; d.bbr[c] = fr * r - fi * i; d.bbi[c] = fr * i + fi * r; }
}

__device__ void s5p1_task(const P& p, int l, int task) {
  const int tid = otid(), lane = tid & 63, wid = __builtin_amdgcn_readfirstlane(tid >> 6);
  const int cq = task % 17, g = (task / 17) % 16, dir = (task / 272) % 2, b = task / 544;
  const int c = cq * 4 + wid;
  S5D d; s5_disc(p, l, dir, g, lane, d);
  float hr = 0.f, hi = 0.f;
  f32x4 ur[4];
  {
    const int pp = c * 64 + lane;
    const int row = pp < 256 ? NLAT + b * 256 + (dir ? 255 - pp : pp) : b * 4096 + (dir ? 4095 - (pp - 256) : pp - 256);
    const float* u = p.Z + (size_t)row * ZS + g * 16;
#pragma unroll
    for (int k = 0; k < 4; ++k) ur[k] = *(const f32x4*)(u + k * 4);
  }
#pragma unroll 4
  for (int i = 0; i < 64; ++i) {
    float bur = 0.f, bui = 0.f;
#pragma unroll
    for (int ch = 0; ch < 16; ++ch) {
      const float uv = __uint_as_float(__builtin_amdgcn_readlane(__float_as_uint(ur[ch >> 2][ch & 3]), i));
      bur += d.bbr[ch] * uv; bui += d.bbi[ch] * uv;
    }
    const float nr = d.ar * hr - d.ai * hi + bur, ni = d.ar * hi + d.ai * hr + bui;
    hr = nr; hi = ni;
  }
  chk(p, 50, hr + hi);
  *(float2*)(p.E + ((size_t)(((b * 2 + dir) * 16 + g) * 68 + c) * 64 + lane) * 2) = make_float2(hr, hi);
}

__device__ void s5p3_task(const P& p, int l, int task, char* lds) {
  const int tid = otid(), lane = tid & 63, wid = __builtin_amdgcn_readfirstlane(tid >> 6);
  const int b = task / 68, tc = task % 68;
  char* my = lds + wid * 12800;
  bf16_t* Hh = (bf16_t*)my; bf16_t* Hl = Hh + 16 * 136; float* Yacc = (float*)(my + 8704);
  const int rowbase = tc < 4 ? NLAT + b * 256 + tc * 64 : b * 4096 + (tc - 4) * 64;
  const int c15 = lane & 15, q4 = lane >> 4;
#pragma unroll 1
  for (int gi = 0; gi < 4; ++gi) {
    const int g = wid * 4 + gi;
    for (int e = lane; e < 1024; e += 64) { int tok = e >> 4, ch = e & 15; Yacc[e] = p.s5_d[l * 256 + g * 16 + ch] * p.Z[(size_t)(rowbase + tok) * ZS + g * 16 + ch]; }
    f32x4 ur[4];
    {
      const float* u = p.Z + (size_t)(rowbase + lane) * ZS + g * 16;
#pragma unroll
      for (int k = 0; k < 4; ++k) ur[k] = *(const f32x4*)(u + k * 4);
    }
#pragma unroll 1
    for (int dir = 0; dir < 2; ++dir) {
      S5D d; s5_disc(p, l, dir, g, lane, d);
      float pr = d.ar, pi = d.ai;
#pragma unroll
      for (int s = 0; s < 6; ++s) { float nr = pr * pr - pi * pi, ni = 2.f * pr * pi; pr = nr; pi = ni; }
      const int cidx = dir ? (tc < 4 ? 3 - tc : 71 - tc) : tc;
      float hr = 0.f, hi = 0.f;
      const float2* Eb = (const float2*)p.E + (size_t)(((b * 2 + dir) * 16 + g) * 68) * 64 + lane;
      {
        int cc = 0;
        for (; cc + 4 <= cidx; cc += 4) {
          const float2 e0 = Eb[cc * 64], e1 = Eb[(cc + 1) * 64], e2 = Eb[(cc + 2) * 64], e3 = Eb[(cc + 3) * 64];
          float nr = pr * hr - pi * hi + e0.x, ni = pr * hi + pi * hr + e0.y; hr = nr; hi = ni;
          nr = pr * hr - pi * hi + e1.x; ni = pr * hi + pi * hr + e1.y; hr = nr; hi = ni;
          nr = pr * hr - pi * hi + e2.x; ni = pr * hi + pi * hr + e2.y; hr = nr; hi = ni;
          nr = pr * hr - pi * hi + e3.x; ni = pr * hi + pi * hr + e3.y; hr = nr; hi = ni;
        }
        for (; cc < cidx; ++cc) { const float2 e = Eb[cc * 64]; const float nr = pr * hr - pi * hi + e.x, ni = pr * hi + pi * hr + e.y; hr = nr; hi = ni; }
      }
      const int idx = (l * 2 + dir) * 16 + g;
      bf16x8 Ch[4], Cl[4];
#pragma unroll
      for (int ks = 0; ks < 4; ++ks) {
        const float* sre = p.c_re + (size_t)(idx * 16 + c15) * 64 + ks * 16 + q4 * 4;
        const float* sim = p.c_im + (size_t)(idx * 16 + c15) * 64 + ks * 16 + q4 * 4;
        float v[8], lo[8];
#pragma unroll
        for (int j = 0; j < 8; ++j) { v[j] = (j & 1) ? -sim[j >> 1] : sre[j >> 1]; lo[j] = v[j] - bf2f(f2bf(v[j])); }
        Ch[ks] = pack8(v[0], v[1], v[2], v[3], v[4], v[5], v[6], v[7]);
        Cl[ks] = pack8(lo[0], lo[1], lo[2], lo[3], lo[4], lo[5], lo[6], lo[7]);
      }
#pragma unroll 1
      for (int sub = 0; sub < 4; ++sub) {
#pragma unroll 2
        for (int ii = 0; ii < 16; ++ii) {
          const int ip = sub * 16 + ii, tok = dir ? 63 - ip : ip;
          float bur = 0.f, bui = 0.f;
#pragma unroll
          for (int ch = 0; ch < 16; ++ch) {
            const float uv = __uint_as_float(__builtin_amdgcn_readlane(__float_as_uint(ur[ch >> 2][ch & 3]), tok));
            bur += d.bbr[ch] * uv; bui += d.bbi[ch] * uv;
          }
          const float nr = d.ar * hr - d.ai * hi + bur, ni = d.ar * hi + d.ai * hr + bui;
          hr = nr; hi = ni;
          const unsigned hpk = pk2(hr, hi);
          ((unsigned*)Hh)[ii * 68 + lane] = hpk;
          ((unsigned*)Hl)[ii * 68 + lane] = pk2(hr - __uint_as_float(hpk << 16), hi - __uint_as_float(hpk & 0xffff0000u));
        }
        __syncthreads();
        f32x4 ya = {0.f, 0.f, 0.f, 0.f};
#pragma unroll
        for (int ks = 0; ks < 4; ++ks) {
          bf16x8 ah = *(const bf16x8*)(Hh + c15 * 136 + ks * 32 + q4 * 8);
          bf16x8 al = *(const bf16x8*)(Hl + c15 * 136 + ks * 32 + q4 * 8);
          ya = mfma16(ah, Ch[ks], ya); ya = mfma16(al, Ch[ks], ya); ya = mfma16(ah, Cl[ks], ya);
        }
#pragma unroll
        for (int j = 0; j < 4; ++j) { const int ip = sub * 16 + q4 * 4 + j, tok = dir ? 63 - ip : ip; Yacc[tok * 16 + c15] += ya[j]; }
        __syncthreads();
      }
    }
    for (int e = lane; e < 1024; e += 64) { int tok = e >> 4, ch = e & 15; __builtin_nontemporal_store(f2bf(geluf_(Yacc[e])), &p.ys[(size_t)(rowbase + tok) * 256 + g * 16 + ch]); }
  }
  asm volatile("s_waitcnt vmcnt(0)" ::: "memory");
  __syncthreads();
  bf16x8 af[8];
  const bf16_t* arow = p.ys + (size_t)(rowbase + wid * 16 + c15) * 256 + q4 * 8;
#pragma unroll
  for (int ks = 0; ks < 8; ++ks) af[ks] = __builtin_nontemporal_load((const bf16x8*)(arow + ks * 32));
#pragma unroll 1
  for (int ct = 0; ct < 16; ++ct) {
    f32x4 a1 = {0.f, 0.f, 0.f, 0.f}, a2 = {0.f, 0.f, 0.f, 0.f};
    const bf16_t* w1 = p.wt_glu + (size_t)(ct * 16 + c15) * 256 + q4 * 8;
    const bf16_t* w2 = w1 + (size_t)256 * 256;
#pragma unroll
    for (int ks = 0; ks < 8; ++ks) {
      a1 = mfma16(af[ks], *(const bf16x8*)(w1 + ks * 32), a1);
      a2 = mfma16(af[ks], *(const bf16x8*)(w2 + ks * 32), a2);
    }
#pragma unroll
    for (int j = 0; j < 4; ++j) {
      const int tok = wid * 16 + q4 * 4 + j;
      chk(p, 80, a1[j] * sigmoidf_(a2[j]));
      p.xn[(size_t)(rowbase + tok) * 1024 + ct * 16 + c15] = DIS_S5 ? (bf16_t)0 : f2bf(a1[j] * sigmoidf_(a2[j]));
    }
  }
  __syncthreads();
}

__device__ void kv_task(const P& p, int l, int task, char* lds) {
  const int tid = otid(), lane = tid & 63, wid = __builtin_amdgcn_readfirstlane(tid >> 6);
  const int rb = task * 64 + wid * 16;
  char* my = lds + wid * 8192;
  bf16_t* Akv = (bf16_t*)my; float* krs = (float*)(my + 4352); float* kss = krs + 512;
  const float* kvnw = p.kvn_w + l * 128;
#pragma unroll 1
  for (int rr = 0; rr < 16; ++rr) {
    const float* z = p.Z + (size_t)(rb + rr) * ZS;
    float2 v = *(const float2*)(z + 512 + lane * 2);
    float ss = wave_sum(v.x * v.x + v.y * v.y);
    const float rinv = rsqrtf(ss * (1.f / 128.f) + EPS);
    float2 w2 = *(const float2*)(kvnw + lane * 2);
    *(unsigned*)(Akv + rr * 136 + lane * 2) = pk2(v.x * rinv * w2.x, v.y * rinv * w2.y);
    float kr = lane < 32 ? z[640 + lane] : 0.f;
    if (lane < 32) krs[rr * 32 + lane] = kr;
    float s2 = wave_sum(kr * kr);
    if (lane == 0) kss[rr] = s2;
  }
  __syncthreads();
  const int c = lane & 15, q = lane >> 4;
  int b, key0; bool lat;
  if (rb < NLAT) { b = rb >> 12; key0 = rb & 4095; lat = true; } else { int rc = rb - NLAT; b = rc >> 8; key0 = 4096 + (rc & 255); lat = false; }
  const float* kg = p.k_gain + l * 96;
#pragma unroll 1
  for (int h = 0; h < 8; ++h) {
    f32x4 acc[8];
#pragma unroll
    for (int ct = 0; ct < 8; ++ct) acc[ct] = (f32x4){0.f, 0.f, 0.f, 0.f};
#pragma unroll
    for (int ks = 0; ks < 4; ++ks) {
      bf16x8 a = *(const bf16x8*)(Akv + c * 136 + ks * 32 + q * 8);
#pragma unroll
      for (int ct = 0; ct < 8; ++ct) {
        bf16x8 bb = *(const bf16x8*)(p.wt_ukv + (size_t)(h * 128 + ct * 16 + c) * 128 + ks * 32 + q * 8);
        acc[ct] = mfma16(a, bb, acc[ct]);
      }
    }
#pragma unroll
    for (int j = 0; j < 4; ++j) {
      const int rr = q * 4 + j;
      float s = acc[0][j] * acc[0][j] + acc[1][j] * acc[1][j] + acc[2][j] * acc[2][j] + acc[3][j] * acc[3][j];
      s += __shfl_xor(s, 1); s += __shfl_xor(s, 2); s += __shfl_xor(s, 4); s += __shfl_xor(s, 8);
      s += kss[rr];
      const float rinv = rsqrtf(s * (1.f / 96.f) + EPS);
      const int key = key0 + rr;
      bf16_t* kd = p.Kb + ((size_t)(b * 8 + h) * 4352 + key) * 96;
#pragma unroll
      for (int ct = 0; ct < 4; ++ct) { const int dd = ct * 16 + c; kd[swap23(dd)] = f2bf(acc[ct][j] * rinv * kg[dd]); }
      float r1 = krs[rr * 32 + c] * rinv * kg[64 + c], r2 = krs[rr * 32 + 16 + c] * rinv * kg[80 + c];
      float o1 = r1, o2 = r2;
      if (lat) {
        const int pos = (c < 8) ? (key >> 6) : (key & 63);
        const float cs = p.rope[(pos * 8 + (c & 7)) * 2], sn = p.rope[(pos * 8 + (c & 7)) * 2 + 1];
        o1 = r1 * cs - r2 * sn; o2 = r1 * sn + r2 * cs;
      }
      chk(p, 40, o1 + o2 + rinv + acc[4][j] + acc[7][j]);
      kd[swap23(64 + c)] = f2bf(o1); kd[swap23(80 + c)] = f2bf(o2);
    }
    const int qs = ((q & 1) << 1) | (q >> 1);
#pragma unroll
    for (int ct = 4; ct < 8; ++ct) {
      const int dv = (ct - 4) * 16 + c;
      bf16_t* vd = p.Vt + ((size_t)(b * 8 + h) * 64 + dv) * 4352 + key0 + qs * 4;
      *(uint2*)vd = make_uint2(pk2(acc[ct][0], acc[ct][1]), pk2(acc[ct][2], acc[ct][3]));
    }
  }
  __syncthreads();
}

__device__ void attn_task(const P& p, int l, int task, char* lds) {
  const int tid = otid(), lane = tid & 63, wid = __builtin_amdgcn_readfirstlane(tid >> 6);
  int qt, h, b;
  if (task < 1024) { qt = task & 31; h = (task >> 5) & 7; b = task >> 8; } else { const int u = task - 1024; qt = 32 + (u & 1); h = (u >> 1) & 7; b = u >> 4; }
  const bool lat = qt < 32;
  const int rowq0 = lat ? b * 4096 + qt * 128 : NLAT + b * 256 + (qt - 32) * 128;
  const int l31 = lane & 31, hh = lane >> 5;
  bf16_t* cqn = (bf16_t*)lds;
  {
    const float* qnw = p.qn_w + l * 256;
    float4 w4 = *(const float4*)(qnw + lane * 4);
#pragma unroll 1
    for (int rr = 0; rr < 32; ++rr) {
      const float* z = p.Z + (size_t)(rowq0 + wid * 32 + rr) * ZS + 256;
      float4 v = *(const float4*)(z + lane * 4);
      float ss = wave_sum(v.x * v.x + v.y * v.y + v.z * v.z + v.w * v.w);
      const float rinv = rsqrtf(ss * (1.f / 256.f) + EPS);
      *(uint2*)(cqn + (wid * 32 + rr) * 256 + lane * 4) = make_uint2(pk2(v.x * rinv * w4.x, v.y * rinv * w4.y), pk2(v.z * rinv * w4.z, v.w * rinv * w4.w));
    }
  }
  __syncthreads();
  bf16x8 qf[6];
  {
    f32x16 qa[3];
#pragma unroll
    for (int bl = 0; bl < 3; ++bl)
#pragma unroll
      for (int e = 0; e < 16; ++e) qa[bl][e] = 0.f;
#pragma unroll 4
    for (int ks = 0; ks < 16; ++ks) {
      bf16x8 bq = *(const bf16x8*)(cqn + (wid * 32 + l31) * 256 + ks * 16 + hh * 8);
#pragma unroll
      for (int bl = 0; bl < 3; ++bl) {
        bf16x8 aw = *(const bf16x8*)(p.wt_uq + (size_t)(h * 96 + bl * 32 + l31) * 256 + ks * 16 + hh * 8);
        qa[bl] = mfma32(aw, bq, qa[bl]);
      }
    }
    float ss = 0.f;
#pragma unroll
    for (int bl = 0; bl < 3; ++bl)
#pragma unroll
      for (int e = 0; e < 16; ++e) ss += qa[bl][e] * qa[bl][e];
    ss += __shfl_xor(ss, 32);
    const float rinv = rsqrtf(ss * (1.f / 96.f) + EPS);
    const float* qg = p.q_gain + l * 96;
#pragma unroll
    for (int bl = 0; bl < 3; ++bl)
#pragma unroll
      for (int e = 0; e < 16; ++e) { const int dd = bl * 32 + 8 * (e >> 2) + 4 * hh + (e & 3); qa[bl][e] *= rinv * qg[dd]; }
    if (lat) {
      const int t = qt * 128 + wid * 32 + l31;
#pragma unroll
      for (int e = 0; e < 8; ++e) {
        const int pos = (e < 4) ? (t >> 6) : (t & 63);
        const int f = 4 * hh + (e & 3);
        const float cs = p.rope[(pos * 8 + f) * 2], sn = p.rope[(pos * 8 + f) * 2 + 1];
        const float r1 = qa[2][e], r2 = qa[2][e + 8];
        qa[2][e] = r1 * cs - r2 * sn; qa[2][e + 8] = r1 * sn + r2 * cs;
      }
    }
    const float sc = 0.10206207261596575f * 1.4426950408889634f;
#pragma unroll
    for (int bl = 0; bl < 3; ++bl)
#pragma unroll
      for (int s = 0; s < 2; ++s)
        qf[bl * 2 + s] = pack8(qa[bl][8 * s + 0] * sc, qa[bl][8 * s + 1] * sc, qa[bl][8 * s + 2] * sc, qa[bl][8 * s + 3] * sc,
                               qa[bl][8 * s + 4] * sc, qa[bl][8 * s + 5] * sc, qa[bl][8 * s + 6] * sc, qa[bl][8 * s + 7] * sc);
  }
  __syncthreads();
  const int nkt = lat ? 68 : 4, kbase = lat ? 0 : 4096;
  const bf16_t* Kg = p.Kb + (size_t)(b * 8 + h) * 4352 * 96;
  const bf16_t* Vg = p.Vt + (size_t)(b * 8 + h) * 64 * 4352;
  char* Ks = lds; char* Vs = lds + 2 * 13312;
  u32x4 rk0[3], rv0[2], rk1[3], rv1[2];
  auto gload = [&](int kt, u32x4 (&rk)[3], u32x4 (&rv)[2]) {
    const int key0 = kbase + kt * 64;
#pragma unroll
    for (int i = 0; i < 3; ++i) { const int idx = tid + i * 256, row = idx / 12, ch = idx % 12; rk[i] = *(const u32x4*)(Kg + (size_t)(key0 + row) * 96 + ch * 8); }
#pragma unroll
    for (int i = 0; i < 2; ++i) { const int idx = tid + i * 256, row = idx >> 3, ch = idx & 7; rv[i] = *(const u32x4*)(Vg + (size_t)row * 4352 + key0 + ch * 8); }
  };
  auto sstore = [&](int buf, const u32x4 (&rk)[3], const u32x4 (&rv)[2]) {
#pragma unroll
    for (int i = 0; i < 3; ++i) { const int idx = tid + i * 256, row = idx / 12, ch = idx % 12; *(u32x4*)(Ks + buf * 13312 + row * 208 + ch * 16) = rk[i]; }
#pragma unroll
    for (int i = 0; i < 2; ++i) { const int idx = tid + i * 256, row = idx >> 3, ch = idx & 7; *(u32x4*)(Vs + buf * 9216 + row * 144 + ch * 16) = rv[i]; }
  };
  f32x16 oacc[2];
#pragma unroll
  for (int bl = 0; bl < 2; ++bl)
#pragma unroll
    for (int e = 0; e < 16; ++e) oacc[bl][e] = 0.f;
  float mrun = -1e30f, lrun = 0.f;
  auto tile = [&](int buf) {
    const char* ksb = Ks + buf * 13312; const char* vsb = Vs + buf * 9216;
    f32x16 sa[2];
#pragma unroll
    for (int kb = 0; kb < 2; ++kb) {
#pragma unroll
      for (int e = 0; e < 16; ++e) sa[kb][e] = 0.f;
#pragma unroll
      for (int st = 0; st < 6; ++st) {
        bf16x8 ak = *(const bf16x8*)(ksb + (kb * 32 + l31) * 208 + (st * 16 + hh * 8) * 2);
        sa[kb] = mfma32(ak, qf[st], sa[kb]);
      }
    }
    float mx = sa[0][0];
#pragma unroll
    for (int kb = 0; kb < 2; ++kb)
#pragma unroll
      for (int e = 0; e < 16; ++e) mx = fmaxf(mx, sa[kb][e]);
    mx = fmaxf(mx, __shfl_xor(mx, 32));
    const float mnew = fmaxf(mrun, mx);
    const float alpha = __builtin_amdgcn_exp2f(mrun - mnew);
    mrun = mnew;
    float ps = 0.f;
#pragma unroll
    for (int kb = 0; kb < 2; ++kb)
#pragma unroll
      for (int e = 0; e < 16; ++e) { float pv = __builtin_amdgcn_exp2f(sa[kb][e] - mnew); sa[kb][e] = pv; ps += pv; }
    lrun = lrun * alpha + ps;
#pragma unroll
    for (int bl = 0; bl < 2; ++bl)
#pragma unroll
      for (int e = 0; e < 16; ++e) oacc[bl][e] *= alpha;
#pragma unroll
    for (int kb = 0; kb < 2; ++kb)
#pragma unroll
      for (int s = 0; s < 2; ++s) {
        bf16x8 pf = pack8(sa[kb][8 * s + 0], sa[kb][8 * s + 1], sa[kb][8 * s + 2], sa[kb][8 * s + 3], sa[kb][8 * s + 4], sa[kb][8 * s + 5], sa[kb][8 * s + 6], sa[kb][8 * s + 7]);
#pragma unroll
        for (int bl = 0; bl < 2; ++bl) {
          bf16x8 av = *(const bf16x8*)(vsb + (bl * 32 + l31) * 144 + (kb * 32 + s * 16 + hh * 8) * 2);
          oacc[bl] = mfma32(av, pf, oacc[bl]);
        }
      }
  };
  gload(0, rk0, rv0); sstore(0, rk0, rv0);
  gload(1, rk0, rv0);
  __syncthreads();
#pragma unroll 1
  for (int kt = 0; kt < nkt; kt += 2) {
    if (kt + 2 < nkt) gload(kt + 2, rk1, rv1);
    tile(0);
    sstore(1, rk0, rv0);
    __syncthreads();
    if (kt + 3 < nkt) gload(kt + 3, rk0, rv0);
    tile(1);
    if (kt + 2 < nkt) sstore(0, rk1, rv1);
    __syncthreads();
  }
  lrun += __shfl_xor(lrun, 32);
  const float linv = 1.f / lrun;
  chk(p, 70, linv + oacc[0][0] + oacc[1][5]);
  bf16_t* orow = p.xn + (size_t)(rowq0 + wid * 32 + l31) * 1024 + 256 + h * 64;
#pragma unroll
  for (int bl = 0; bl < 2; ++bl)
#pragma unroll
    for (int e4 = 0; e4 < 4; ++e4) {
      const int dv = bl * 32 + 8 * e4 + 4 * hh;
      *(uint2*)(orow + dv) = DIS_ATT ? make_uint2(0u, 0u) : make_uint2(pk2(oacc[bl][e4 * 4 + 0] * linv, oacc[bl][e4 * 4 + 1] * linv), pk2(oacc[bl][e4 * 4 + 2] * linv, oacc[bl][e4 * 4 + 3] * linv));
    }
  __syncthreads();
}

__device__ void dnprep_task(const P& p, int l, int task, char* lds) {
  const int tid = otid(), lane = tid & 63, wid = __builtin_amdgcn_readfirstlane(tid >> 6);
  const int d = task & 1, h = (task >> 1) & 3, sc = (task >> 3) % 68, b = task / (8 * 68);
  const int L = sc < 64 ? 4096 : 256, t0 = sc < 64 ? sc * 64 : (sc - 64) * 64, rowbase = sc < 64 ? b * 4096 : NLAT + b * 256;
  bf16_t* qsb = (bf16_t*)lds; float* ks = (float*)(lds + 8448); float* vs = ks + 64 * 65; float* Am = vs + 64 * 65;
  float* gc = Am + 4096; float* be = gc + 64; float* eg = be + 64;
  bf16_t* ob = p.dnop + ((size_t)(((b * 4 + h) * 2 + d) * 68 + sc) * 5) * 4096;
  bf16_t *NWK = ob, *WVT = ob + 4096, *QD = ob + 8192, *AT = ob + 12288, *KDT = ob + 16384;
  if (wid == 0) {
    const int ip = lane, i = d ? 63 - ip : ip;
    const float* ba = p.Z + (size_t)(rowbase + t0 + i) * ZS + 1696;
    const float bl = ba[d * 4 + h], dl = ba[8 + d * 4 + h];
    const float beta = sigmoidf_(bl);
    const float xx = dl + p.dt_bias[(l * 2 + d) * 4 + h];
    const float sp = fmaxf(xx, 0.f) + log1pf(expf(-fabsf(xx)));
    float g = -expf(p.a_log[(l * 2 + d) * 4 + h]) * sp;
#pragma unroll
    for (int o = 1; o < 64; o <<= 1) { float t = __shfl_up(g, o); if (lane >= o) g += t; }
    gc[ip] = g; be[ip] = beta; eg[ip] = expf(g);
    if (ip == 63) p.gl[(((b * 4 + h) * 2 + d) * 68 + sc) * 32] = expf(g);
  }
  {
    const int ch = lane, tg = wid;
    const int tb = d ? t0 + 63 - (tg * 16 + 15) : t0 + tg * 16;
#pragma unroll 1
    for (int arr = 0; arr < 3; ++arr) {
      const int chan = arr * 256 + h * 64 + ch;
      float w[5];
#pragma unroll
      for (int j = 0; j < 5; ++j) w[j] = p.conv_w[(size_t)(l * 5 + j) * 768 + chan];
      float x[20];
#pragma unroll
      for (int k = 0; k < 20; ++k) { const int tt = tb - 2 + k; x[k] = (tt >= 0 && tt < L) ? p.Z[(size_t)(rowbase + tt) * ZS + 672 + chan] : 0.f; }
#pragma unroll
      for (int m = 0; m < 16; ++m) {
        float y = w[0] * x[m] + w[1] * x[m + 1] + w[2] * x[m + 2] + w[3] * x[m + 3] + w[4] * x[m + 4];
        y = siluf_(y);
        if (arr < 2) { float ss = wave_sum(y * y); y *= rsqrtf(ss + EPS); }
        const int i = tb + m - t0, ip = d ? 63 - i : i;
        if (arr == 0) qsb[ip * 66 + ch] = f2bf(y); else (arr == 1 ? ks : vs)[ip * 65 + ch] = y;
      }
    }
  }
  __syncthreads();
  {
    const int ti = tid >> 4, tj = tid & 15;
    float qk[4][4];
#pragma unroll
    for (int a = 0; a < 4; ++a)
#pragma unroll
      for (int bb = 0; bb < 4; ++bb) qk[a][bb] = 0.f;
#pragma unroll 4
    for (int c = 0; c < 64; ++c) {
      float qi[4], kj[4];
#pragma unroll
      for (int a = 0; a < 4; ++a) { qi[a] = bf2f(qsb[(4 * ti + a) * 66 + c]); kj[a] = ks[(4 * tj + a) * 65 + c]; }
#pragma unroll
      for (int a = 0; a < 4; ++a)
#pragma unroll
        for (int bb = 0; bb < 4; ++bb) qk[a][bb] += qi[a] * kj[bb];
    }
#pragma unroll
    for (int a = 0; a < 4; ++a) {
      const int ip = 4 * ti + a, tok_i = d ? 63 - ip : ip;
      float at[4];
#pragma unroll
      for (int bb = 0; bb < 4; ++bb) {
        const int jp = 4 * tj + bb;
        const float dec = (ip >= jp) ? expf(gc[ip] - gc[jp]) : 0.f;
        at[bb] = qk[a][bb] * 0.125f * dec;
      }
      const int tokj0 = d ? 60 - 4 * tj : 4 * tj;
      const int p0 = kpinv(tokj0);
      uint2 pkv = d ? make_uint2(pk2(at[3], at[2]), pk2(at[1], at[0])) : make_uint2(pk2(at[0], at[1]), pk2(at[2], at[3]));
      *(uint2*)(AT + tok_i * 64 + p0) = pkv;
    }
  }
  {
    float krow[64];
#pragma unroll
    for (int c = 0; c < 64; ++c) krow[c] = ks[lane * 65 + c];
    const float bi = be[lane], gi_ = gc[lane];
#pragma unroll 1
    for (int jj = 0; jj < 16; ++jj) {
      const int j = wid * 16 + jj;
      const float* kjp = ks + j * 65;
      float dot = 0.f;
#pragma unroll
      for (int c = 0; c < 64; ++c) dot = fmaf(krow[c], kjp[c], dot);
      Am[j * 64 + lane] = (lane > j) ? dot * bi * expf(gi_ - gc[j]) : 0.f;
    }
  }
  __syncthreads();
  {
    const float glast = gc[63];
#pragma unroll 1
    for (int it = 0; it < 2; ++it) {
      const int ct = tid + it * 256;
      const int r = ct >> 3, pb = (ct & 7) * 8;
      {
        const int ip = d ? 63 - r : r;
        const float s = 0.125f * eg[ip];
        float e[8];
#pragma unroll
        for (int k = 0; k < 8; ++k) { e[k] = bf2f(qsb[ip * 66 + kperm(pb + k)]) * s; chk(p, 61, e[k]); }
        *(bf16x8*)(QD + r * 64 + pb) = pack8(e[0], e[1], e[2], e[3], e[4], e[5], e[6], e[7]);
      }
      {
        float e[8];
#pragma unroll
        for (int k = 0; k < 8; ++k) { const int tok = kperm(pb + k), jp = d ? 63 - tok : tok; e[k] = ks[jp * 65 + r] * expf(glast - gc[jp]); chk(p, 62, e[k]); }
        *(bf16x8*)(KDT + r * 64 + pb) = pack8(e[0], e[1], e[2], e[3], e[4], e[5], e[6], e[7]);
      }
    }
  }
  __syncthreads();
  {
    const float* Wm = (wid < 2) ? vs : ks;
    float Arow[64];
#pragma unroll
    for (int j = 0; j < 64; ++j) Arow[j] = Am[j * 64 + lane];
    const float rs = be[lane] * ((wid >= 2) ? eg[lane] : 1.f);
    const int c0 = (wid & 1) * 32;
    const int tok = d ? 63 - lane : lane;
#pragma unroll 1
    for (int c = c0; c < c0 + 32; c += 4) {
      float a0 = Wm[lane * 65 + c] * rs, a1 = Wm[lane * 65 + c + 1] * rs, a2 = Wm[lane * 65 + c + 2] * rs, a3 = Wm[lane * 65 + c + 3] * rs;
#pragma unroll
      for (int j = 0; j < 63; ++j) {
        const float w0 = __uint_as_float(__builtin_amdgcn_readlane(__float_as_uint(a0), j));
        const float w1 = __uint_as_float(__builtin_amdgcn_readlane(__float_as_uint(a1), j));
        const float w2 = __uint_as_float(__builtin_amdgcn_readlane(__float_as_uint(a2), j));
        const float w3 = __uint_as_float(__builtin_amdgcn_readlane(__float_as_uint(a3), j));
        a0 = fmaf(-Arow[j], w0, a0); a1 = fmaf(-Arow[j], w1, a1); a2 = fmaf(-Arow[j], w2, a2); a3 = fmaf(-Arow[j], w3, a3);
      }
      if (wid < 2) {
        WVT[c * 64 + tok] = f2bf(a0); WVT[(c + 1) * 64 + tok] = f2bf(a1); WVT[(c + 2) * 64 + tok] = f2bf(a2); WVT[(c + 3) * 64 + tok] = f2bf(a3);
      } else {
        NWK[tok * 64 + kpinv(c)] = f2bf(-a0); NWK[tok * 64 + kpinv(c + 1)] = f2bf(-a1); NWK[tok * 64 + kpinv(c + 2)] = f2bf(-a2); NWK[tok * 64 + kpinv(c + 3)] = f2bf(-a3);
      }
    }
  }
  __syncthreads();
}

__device__ void dnrec_task(const P& p, int l, int task, char* lds) {
  const int tid = otid(), lane = tid & 63, wid = __builtin_amdgcn_readfirstlane(tid >> 6);
  const int d = task & 1, h = (task >> 1) & 3, b = task >> 3;
  const int c = lane & 15, q = lane >> 4;
  const int dv = wid * 16 + c;
  const char* LN = lds; const char* LW = lds + 9216; const char* LQ = lds + 18432; const char* LA = lds + 27648; const char* LK = lds + 36864;
  bf16_t* osd = (bf16_t*)p.os + (size_t)d * NROWS * 256;
  f32x4 S[4];
#pragma unroll
  for (int mt = 0; mt < 4; ++mt) S[mt] = (f32x4){0.f, 0.f, 0.f, 0.f};
  u32x4 pre[10];
  auto opblk = [&](int n) -> const char* {
    const int sc = d ? 67 - n : (n < 4 ? 64 + n : n - 4);
    return (const char*)(p.dnop + ((size_t)(((b * 4 + h) * 2 + d) * 68 + sc) * 5) * 4096);
  };
  auto prefetch = [&](int n) {
    const char* ob = opblk(n);
#pragma unroll
    for (int i = 0; i < 10; ++i) pre[i] = *(const u32x4*)(ob + (size_t)(tid + i * 256) * 16);
  };
  auto stage = [&]() {
#pragma unroll
    for (int i = 0; i < 10; ++i) { const int idx = tid + i * 256, m = idx >> 9, r = (idx >> 3) & 63, ch = idx & 7; *(u32x4*)(lds + m * 9216 + r * 144 + ch * 16) = pre[i]; }
  };
  prefetch(0);
#pragma unroll 1
  for (int n = 0; n < 68; ++n) {
    const int sc = d ? 67 - n : (n < 4 ? 64 + n : n - 4);
    const int rowb = sc < 64 ? b * 4096 + sc * 64 : NLAT + b * 256 + (sc - 64) * 64;
    const float egl = p.gl[(((b * 4 + h) * 2 + d) * 68 + sc) * 32];
    __syncthreads();
    stage();
    __syncthreads();
    if (n + 1 < 68) prefetch(n + 1);
    bf16x8 sb[2];
#pragma unroll
    for (int ks = 0; ks < 2; ++ks)
      sb[ks] = pack8(S[2 * ks][0], S[2 * ks][1], S[2 * ks][2], S[2 * ks][3], S[2 * ks + 1][0], S[2 * ks + 1][1], S[2 * ks + 1][2], S[2 * ks + 1][3]);
    f32x4 va[4];
#pragma unroll
    for (int mt = 0; mt < 4; ++mt) {
      uint2 wv = *(const uint2*)(LW + dv * 144 + (mt * 16 + q * 4) * 2);
      va[mt] = (f32x4){__uint_as_float(wv.x << 16), __uint_as_float(wv.x & 0xffff0000u), __uint_as_float(wv.y << 16), __uint_as_float(wv.y & 0xffff0000u)};
#pragma unroll
      for (int ks = 0; ks < 2; ++ks) {
        bf16x8 a = *(const bf16x8*)(LN + (mt * 16 + c) * 144 + (ks * 32 + q * 8) * 2);
        va[mt] = mfma16(a, sb[ks], va[mt]);
      }
    }
    bf16x8 vb[2];
#pragma unroll
    for (int ks = 0; ks < 2; ++ks)
      vb[ks] = pack8(va[2 * ks][0], va[2 * ks][1], va[2 * ks][2], va[2 * ks][3], va[2 * ks + 1][0], va[2 * ks + 1][1], va[2 * ks + 1][2], va[2 * ks + 1][3]);
#pragma unroll
    for (int mt = 0; mt < 4; ++mt) {
      f32x4 oa = {0.f, 0.f, 0.f, 0.f};
#pragma unroll
      for (int ks = 0; ks < 2; ++ks) {
        bf16x8 a = *(const bf16x8*)(LQ + (mt * 16 + c) * 144 + (ks * 32 + q * 8) * 2);
        oa = mfma16(a, sb[ks], oa);
        bf16x8 a2 = *(const bf16x8*)(LA + (mt * 16 + c) * 144 + (ks * 32 + q * 8) * 2);
        oa = mfma16(a2, vb[ks], oa);
      }
      bf16_t* od = osd + (size_t)(rowb + mt * 16 + q * 4) * 256 + h * 64 + dv;
#pragma unroll
      for (int j = 0; j < 4; ++j) od[(size_t)j * 256] = f2bf(oa[j]);
    }
#pragma unroll
    for (int mt = 0; mt < 4; ++mt) {
      f32x4 sn = S[mt] * egl;
#pragma unroll
      for (int ks = 0; ks < 2; ++ks) {
        bf16x8 a = *(const bf16x8*)(LK + (mt * 16 + c) * 144 + (ks * 32 + q * 8) * 2);
        sn = mfma16(a, vb[ks], sn);
      }
      S[mt] = sn;
    }
  }
  __syncthreads();
}

__device__ void dnfin_task(const P& p, int l, int task) {
  const int tid = otid();
  const int row = task * 64 + (tid >> 2), h = tid & 3;
  const bf16_t* o0 = (const bf16_t*)p.os + (size_t)row * 256 + h * 64;
  const bf16_t* o1 = o0 + (size_t)NROWS * 256;
  const float* gt = p.Z + (size_t)row * ZS + 1440 + h * 64;
  const float* nw = p.dn_norm_w + l * 64;
  bf16_t* dst = p.xn + (size_t)row * 1024 + 768 + h * 64;
  float ss = 0.f;
#pragma unroll
  for (int k = 0; k < 8; ++k) {
    const u32x4 a = *(const u32x4*)(o0 + k * 8), bq = *(const u32x4*)(o1 + k * 8);
#pragma unroll
    for (int e = 0; e < 4; ++e) {
      const float v0 = __uint_as_float(a[e] << 16) + __uint_as_float(bq[e] << 16);
      const float v1 = __uint_as_float(a[e] & 0xffff0000u) + __uint_as_float(bq[e] & 0xffff0000u);
      ss += v0 * v0 + v1 * v1;
    }
  }
  const float rinv = rsqrtf(ss * (1.f / 64.f) + EPS);
#pragma unroll
  for (int k = 0; k < 8; ++k) {
    const u32x4 a = *(const u32x4*)(o0 + k * 8), bq = *(const u32x4*)(o1 + k * 8);
    const f32x4 g0 = *(const f32x4*)(gt + k * 8), g1 = *(const f32x4*)(gt + k * 8 + 4);
    const f32x4 w0 = *(const f32x4*)(nw + k * 8), w1 = *(const f32x4*)(nw + k * 8 + 4);
    float o[8];
#pragma unroll
    for (int e = 0; e < 4; ++e) {
      o[2 * e] = __uint_as_float(a[e] << 16) + __uint_as_float(bq[e] << 16);
      o[2 * e + 1] = __uint_as_float(a[e] & 0xffff0000u) + __uint_as_float(bq[e] & 0xffff0000u);
    }
    u32x4 r;
    r[0] = pk2(o[0] * rinv * w0[0] * siluf_(g0[0]), o[1] * rinv * w0[1] * siluf_(g0[1]));
    r[1] = pk2(o[2] * rinv * w0[2] * siluf_(g0[2]), o[3] * rinv * w0[3] * siluf_(g0[3]));
    r[2] = pk2(o[4] * rinv * w1[0] * siluf_(g1[0]), o[5] * rinv * w1[1] * siluf_(g1[1]));
    r[3] = pk2(o[6] * rinv * w1[2] * siluf_(g1[2]), o[7] * rinv * w1[3] * siluf_(g1[3]));
    *(u32x4*)(dst + k * 8) = r;
  }
}

struct Bar { unsigned epoch, nx, nxcd; int xcc; unsigned* garr; unsigned* arr; };
DEV int xcc_id() { return (int)(__builtin_amdgcn_s_getreg(6164) & 15u); }
DEV void gbar(Bar& b) {
  asm volatile("s_waitcnt vmcnt(0) lgkmcnt(0)" ::: "memory");
  __syncthreads();
  b.epoch += 1;
  if (threadIdx.x == 0) {
    const unsigned old = __hip_atomic_fetch_add(b.arr, 1u, __ATOMIC_RELAXED, __HIP_MEMORY_SCOPE_AGENT);
    if (old + 1 == b.epoch * b.nx) {
      __builtin_amdgcn_fence(__ATOMIC_RELEASE, "agent");
      asm volatile("s_waitcnt vmcnt(0)" ::: "memory");
      __hip_atomic_fetch_add(b.garr, 1u, __ATOMIC_RELAXED, __HIP_MEMORY_SCOPE_AGENT);
    }
    const unsigned target = b.epoch * b.nxcd;
    while (__hip_atomic_load(b.garr, __ATOMIC_RELAXED, __HIP_MEMORY_SCOPE_AGENT) < target) __builtin_amdgcn_s_sleep(2);
    __builtin_amdgcn_fence(__ATOMIC_ACQUIRE, "agent");
    asm volatile("s_waitcnt vmcnt(0)" ::: "memory");
  }
  __syncthreads();
}
DEV void gsync(cg::grid_group& grid) {
  asm volatile("s_waitcnt vmcnt(0) lgkmcnt(0)" ::: "memory");
  grid.sync();
  if (threadIdx.x < 64) {
    __builtin_amdgcn_fence(__ATOMIC_ACQUIRE, "agent");
    asm volatile("s_waitcnt vmcnt(0)" ::: "memory");
  }
  __syncthreads();
}

__device__ void run_phase(const P& p, int ph, char* lds) {
  const int tid = threadIdx.x;
  if (ph == 0) {
    phase0(p, lds);
    return;
  }
  const int l = (ph - 1) / 11, q = (ph - 1) % 11;
  const int Mt = (l < 3) ? 136 : 128;
  switch (q) {
    case 0: {
      const int nnorm = 1088;
      for (int t = blockIdx.x; t < nnorm + 2864; t += gridDim.x) {
        if (t < nnorm) { norm_task(p, l, 0, t); continue; }
        int u = t - nnorm;
        float* tile = (float*)lds;
        if (u < 448) { conv_tile(p.w_in + (size_t)l * 1024 * 1712, 1024, 1712, p.wt_in, u / 28, u % 28, tile); continue; } u -= 448;
        if (u < 256) { conv_tile(p.w_out + (size_t)l * 1024 * 1024, 1024, 1024, p.wt_out, u / 16, u % 16, tile); continue; } u -= 256;
        if (u < 1024) { conv_tile(p.w_ff1 + (size_t)l * 1024 * 4096, 1024, 4096, p.wt_ff1, u / 64, u % 64, tile); continue; } u -= 1024;
        if (u < 1024) { conv_tile(p.w_ff2 + (size_t)l * 4096 * 1024, 4096, 1024, p.wt_ff2, u / 16, u % 16, tile); continue; } u -= 1024;
        if (u < 48) { conv_tile(p.w_uq + (size_t)l * 256 * 768, 256, 768, p.wt_uq, u / 12, u % 12, tile); continue; } u -= 48;
        if (u < 32) { conv_tile(p.w_ukv + (size_t)l * 128 * 1024, 128, 1024, p.wt_ukv, u / 16, u % 16, tile); continue; } u -= 32;
        conv_tile(p.glu_w + (size_t)l * 256 * 512, 256, 512, p.wt_glu, u / 8, u % 8, tile);
      }
    } break;
    case 1: gemm_phase<0>(p, l, p.xn, 1024, p.wt_in, 1024, 136, 14, 1024, 0, lds); break;
    case 2:
      for (int t = blockIdx.x; t < 272 + 2176; t += gridDim.x) {
        if (t < 2176) dnprep_task(p, l, t, lds);
        else kv_task(p, l, t - 2176, lds);
      }
      break;
    case 3:
      {
        const int natt = 1024 + (l == 3 ? 0 : 64);
        const int nt = 32 + natt + 2176;
        int* slot = (int*)(lds + LDS_BYTES - 16);
        unsigned* qc = p.ctr + 16 + l;
        while (true) {
          __syncthreads();
          if (threadIdx.x == 0) *slot = (int)atomicAdd(qc, 1u);
          __syncthreads();
          const int t = *slot;
          __syncthreads();
          if (t >= nt) break;
          if (t < 32) dnrec_task(p, l, t, lds);
          else if (t < 32 + natt) attn_task(p, l, t - 32, lds);
          else s5p1_task(p, l, t - 32 - natt);
        }
      }
      break;
    case 4: {
      const int nt = 272 + 272;
      int* slot = (int*)(lds + LDS_BYTES - 16);
      unsigned* qc = p.ctr + 8 + l;
      while (true) {
        __syncthreads();
        if (threadIdx.x == 0) *slot = (int)atomicAdd(qc, 1u);
        __syncthreads();
        const int t = *slot;
        __syncthreads();
        if (t >= nt) break;
        if (t < 272) s5p3_task(p, l, t, lds);
        else dnfin_task(p, l, t - 272);
      }
    } break;
    case 5: break;
    case 6: gemm_phase<1>(p, l, p.xn, 1024, p.wt_out, 1024, Mt, 8, 1024, 2, lds); break;
    case 7: for (int t = blockIdx.x; t < Mt * 8; t += gridDim.x) norm_task(p, l, 1, t); break;
    case 8: gemm_phase<2>(p, l, p.xn, 1024, p.wt_ff1, 1024, Mt, 32, 1024, 0, lds); break;
    case 9: gemm_phase<1>(p, l, p.H, 4096, p.wt_ff2, 4096, Mt, 8, 4096, 5, lds); break;
    default: break;
  }
}


#define NPH 45
__global__ void __launch_bounds__(256, 2) fwd_megakernel(P p, int pb, int pe) {
  extern __shared__ __attribute__((aligned(16))) char lds[];
  cg::grid_group grid = cg::this_grid();
  Bar bar;
  bar.epoch = 0; bar.xcc = xcc_id(); bar.garr = p.ctr + 64; bar.arr = p.ctr + 1024 + bar.xcc * 32; bar.nx = 0; bar.nxcd = 0;
  if (threadIdx.x == 0) __hip_atomic_fetch_add(p.ctr + 256 + bar.xcc * 32, 1u, __ATOMIC_RELAXED, __HIP_MEMORY_SCOPE_AGENT);
#pragma unroll 1
  for (int ph = pb; ph < pe; ++ph) {
    const int q = (ph - 1) % 11;
    const int nrep = ((ph >= 1 && REPQ >= 0 && q == REPQ) || (ph == 0 && REPQ == 100)) ? 2 : 1;
#pragma unroll 1
    for (int rep = 0; rep < nrep; ++rep) {
      run_phase(p, ph, lds);
      if ((ph + 1 < pe || rep + 1 < nrep) && !(ph >= 1 && (q == 5 || q == 10))) {
        if (ph == 0 && rep == 0) {
          gsync(grid);
          unsigned nxcd = 0;
          for (int x = 0; x < 16; ++x) nxcd += (__hip_atomic_load(p.ctr + 256 + x * 32, __ATOMIC_RELAXED, __HIP_MEMORY_SCOPE_AGENT) != 0u) ? 1u : 0u;
          bar.nxcd = nxcd;
          bar.nx = __hip_atomic_load(p.ctr + 256 + bar.xcc * 32, __ATOMIC_RELAXED, __HIP_MEMORY_SCOPE_AGENT);
        } else gbar(bar);
      }
    }
  }
}

extern "C" void kernel_launch(void* const* d_in, const int* in_sizes, int n_in, void* d_out, int out_size, void* d_ws, size_t ws_size, hipStream_t stream) {
  P p{};
  const float** fp = (const float**)&p;
  for (int i = 0; i < 31; ++i) fp[i] = (const float*)d_in[i];
  p.out = (float*)d_out;
  char* w = (char*)d_ws;
  size_t off = 0;
  auto take = [&](size_t bytes) { char* r = w + off; off += (bytes + 255) & ~(size_t)255; return r; };
  p.ctr = (unsigned*)take(8192);
  p.wt_in = (bf16_t*)take((size_t)1792 * 1024 * 2);
  p.wt_out = (bf16_t*)take((size_t)1024 * 1024 * 2);
  p.wt_ff1 = (bf16_t*)take((size_t)4096 * 1024 * 2);
  p.wt_ff2 = (bf16_t*)take((size_t)1024 * 4096 * 2);
  p.wt_uq = (bf16_t*)take((size_t)768 * 256 * 2);
  p.wt_ukv = (bf16_t*)take((size_t)1024 * 128 * 2);
  p.wt_glu = (bf16_t*)take((size_t)512 * 256 * 2);
  p.mods = (float*)take((size_t)4 * 5 * 6144 * 4);
  p.rope = (float*)take(4096);
  p.xc = (float*)take((size_t)1024 * 1024 * 4);
  p.xn = (bf16_t*)take((size_t)NROWS * 1024 * 2);
  p.E = (float*)take((size_t)128 * 68 * 64 * 2 * 4);
  p.os = (float*)take((size_t)NROWS * 256 * 4);
  p.gl = (float*)take((size_t)4 * 4 * 2 * 68 * 4 * 32);
  p.ys = (bf16_t*)take((size_t)NROWS * 256 * 2);
  p.dnop = (bf16_t*)take((size_t)4 * 4 * 2 * 68 * 5 * 4096 * 2);
  char* r1 = take((size_t)NROWS * ZS * 4 + (size_t)32 * 4352 * 96 * 2 + (size_t)32 * 64 * 4352 * 2);
  p.Z = (float*)r1;
  p.Kb = (bf16_t*)(r1 + (size_t)NROWS * ZS * 4);
  p.Vt = (bf16_t*)(r1 + (size_t)NROWS * ZS * 4 + (size_t)32 * 4352 * 96 * 2);
  p.H = (bf16_t*)r1;
  p.fill_begin = (u32x4*)((char*)p.xc); p.fill_n = (size_t)((w + off) - (char*)p.xc) / 16;
  if (off > ws_size) { fprintf(stderr, "workspace too small: need %zu have %zu\n", off, ws_size); return; }
  hipMemsetAsync(p.ctr, 0, 8192, stream);
  hipFuncSetAttribute((const void*)fwd_megakernel, hipFuncAttributeMaxDynamicSharedMemorySize, LDS_BYTES);
  int dev = 0, cus = 0, per_cu = 0;
  hipGetDevice(&dev);
  hipDeviceGetAttribute(&cus, hipDeviceAttributeMultiprocessorCount, dev);
  hipOccupancyMaxActiveBlocksPerMultiprocessor(&per_cu, fwd_megakernel, 256, LDS_BYTES);
  if (per_cu > 2) per_cu = 2;
  int grid_blocks = cus * per_cu;
#ifdef MULTI_LAUNCH
  hipError_t e = hipSuccess;
  for (int ph = 0; ph < NPH; ++ph) fwd_megakernel<<<dim3(grid_blocks), dim3(256), LDS_BYTES, stream>>>(p, ph, ph + 1);
#else
  int pb = 0, pe = NPH;
  void* args[] = {&p, &pb, &pe};
  hipError_t e = hipLaunchCooperativeKernel((void*)fwd_megakernel, dim3(grid_blocks), dim3(256), args, LDS_BYTES, stream);
#endif
  if (e != hipSuccess) fprintf(stderr, "cooperative launch failed: %s (grid %d)\n", hipGetErrorString(e), grid_blocks);
}
```
